# Optimizing an MI355X kernel written in HIP

```python
import jax, jax.numpy as jnp
from jax import lax
import numpy as np

D_MODEL = 4096
BATCH = 2
SEQ = 8192
DEPTH = 2

CONV_CH = D_MODEL // 4
CONV_WIDTH = 31
SCONV_CH = D_MODEL // 4
SCONV_WIDTH = 3
ATTN_CH = D_MODEL // 4
HEAD_DIM = 64
N_Q_HEADS = ATTN_CH // HEAD_DIM
N_KV_HEADS = N_Q_HEADS // 8
GQA_GROUP = N_Q_HEADS // N_KV_HEADS
WINDOW = 128
BLOCK = 128
POOL_CH = D_MODEL // 4
POOL_WINDOWS = (2, 4, 8, 16)
POOL_GROUP = POOL_CH // len(POOL_WINDOWS)
D_FF = 4 * D_MODEL
PLE_DIM = 256
EPS = 1e-6

A_COLS = 2 * CONV_CH
B_COLS = 3 * SCONV_CH
Q_COLS = N_Q_HEADS * HEAD_DIM
KV_COLS = N_KV_HEADS * HEAD_DIM
D_COLS = POOL_CH
SPLIT_POINTS = (A_COLS, A_COLS + B_COLS, A_COLS + B_COLS + Q_COLS,
                A_COLS + B_COLS + Q_COLS + KV_COLS,
                A_COLS + B_COLS + Q_COLS + 2 * KV_COLS)
IN_COLS = A_COLS + B_COLS + Q_COLS + 2 * KV_COLS + D_COLS

kernel_name = "hybrid_parallel_conformer_shortconv_swa_pool"


def rmsnorm(x, g):
    xf = x.astype(jnp.float32)
    y = xf * lax.rsqrt(jnp.mean(xf * xf, axis=-1, keepdims=True) + EPS)
    return (y * g.astype(jnp.float32)).astype(x.dtype)


def rms_scale(x):
    xf = x.astype(jnp.float32)
    return (xf * lax.rsqrt(jnp.mean(xf * xf, axis=-1, keepdims=True) + EPS)).astype(x.dtype)


def layernorm(x, g, b):
    xf = x.astype(jnp.float32)
    mu = jnp.mean(xf, axis=-1, keepdims=True)
    var = jnp.mean(jnp.square(xf - mu), axis=-1, keepdims=True)
    y = (xf - mu) * lax.rsqrt(var + EPS)
    return (y * g.astype(jnp.float32) + b.astype(jnp.float32)).astype(x.dtype)


def depthwise_causal_conv(u, w):
    k = w.shape[0]
    return lax.conv_general_dilated(
        u, w[:, None, :].astype(u.dtype), window_strides=(1,), padding=[(k - 1, 0)],
        dimension_numbers=("NWC", "WIO", "NWC"), feature_group_count=u.shape[-1])


def conformer_conv(za, conv_w, conv_b, ln_g, ln_b):
    val, gate = jnp.split(za, 2, axis=-1)
    u = val * jax.nn.sigmoid(gate)
    u = depthwise_causal_conv(u, conv_w) + conv_b
    u = layernorm(u, ln_g, ln_b)
    return jax.nn.silu(u)


def short_gated_conv(zb, sconv_w):
    bg, cg, xin = jnp.split(zb, 3, axis=-1)
    return bg * depthwise_causal_conv(cg * xin, sconv_w)


def alibi_slopes():
    return jnp.exp2(-8.0 * jnp.arange(1, N_Q_HEADS + 1, dtype=jnp.float32) / N_Q_HEADS)


def sliding_window_attention(q, k, v, sinks):
    b, s = q.shape[:2]
    nb = s // BLOCK
    qb = q.reshape(b, nb, BLOCK, N_KV_HEADS, GQA_GROUP, HEAD_DIM)
    kb = k.reshape(b, nb, BLOCK, N_KV_HEADS, HEAD_DIM)
    vb = v.reshape(b, nb, BLOCK, N_KV_HEADS, HEAD_DIM)
    pad = ((0, 0), (1, 0), (0, 0), (0, 0), (0, 0))
    kk = jnp.concatenate([jnp.pad(kb, pad)[:, :-1], kb], axis=2)
    vv = jnp.concatenate([jnp.pad(vb, pad)[:, :-1], vb], axis=2)
    scores = jnp.einsum("bnqhgd,bnkhd->bnhgqk", qb, kk).astype(jnp.float32)
    scores = scores * (1.0 / np.sqrt(HEAD_DIM)).astype(np.float32)
    qi = jnp.arange(BLOCK)[:, None]
    kj = jnp.arange(2 * BLOCK)[None, :]
    dist = qi + BLOCK - kj
    in_window = (dist >= 0) & (dist < WINDOW)
    before_start = (jnp.arange(nb)[:, None, None] == 0) & (kj < BLOCK)[None]
    valid = in_window[None] & ~before_start
    alibi = -alibi_slopes()[:, None, None] * dist.astype(jnp.float32)[None]
    scores = scores + alibi.reshape(N_KV_HEADS, GQA_GROUP, BLOCK, 2 * BLOCK)
    scores = jnp.where(valid[None, :, None, None], scores, jnp.float32(-1e30))
    sink = jnp.broadcast_to(
        sinks.astype(jnp.float32).reshape(1, 1, N_KV_HEADS, GQA_GROUP, 1, 1),
        scores.shape[:-1] + (1,))
    probs = jax.nn.softmax(jnp.concatenate([scores, sink], axis=-1), axis=-1)[..., :-1]
    out = jnp.einsum("bnhgqk,bnkhd->bnqhgd", probs.astype(vv.dtype), vv)
    return out.reshape(b, s, N_Q_HEADS * HEAD_DIM)


def multiscale_pool(u, pool_w, pool_scale):
    b, s = u.shape[:2]
    uf = u.astype(jnp.float32).reshape(b, s, len(POOL_WINDOWS), POOL_GROUP)
    cs = jnp.pad(jnp.cumsum(uf, axis=1), ((0, 0), (1, 0), (0, 0), (0, 0)))
    t = jnp.arange(s)
    groups = []
    for gi, w in enumerate(POOL_WINDOWS):
        seg = cs[:, :, gi]
        start = jnp.maximum(t + 1 - w, 0)
        count = jnp.minimum(t + 1, w).astype(jnp.float32)[None, :, None]
        groups.append((seg[:, 1:] - seg[:, start]) / count - uf[:, :, gi])
    z = jnp.stack(groups, axis=2).astype(u.dtype)
    z = jnp.einsum("bsgc,gcd->bsgd", z, pool_w).reshape(b, s, POOL_CH)
    return z * pool_scale


def setup_inputs(seed: int = 0) -> dict:
    key = jax.random.key(seed)
    ks = jax.random.split(key, 24)
    f32 = jnp.float32

    def nrm(k, shape, scale):
        return jax.random.normal(k, shape, f32) * scale

    def gain(k, shape):
        return 1.0 + 0.05 * jax.random.normal(k, shape, f32)

    return {
        "x": nrm(ks[0], (BATCH, SEQ, D_MODEL), 1.0),
        "p": nrm(ks[1], (DEPTH, BATCH, SEQ, PLE_DIM), 1.0),
        "norm_mix": gain(ks[2], (DEPTH, D_MODEL)),
        "w_in": nrm(ks[3], (DEPTH, D_MODEL, IN_COLS), D_MODEL ** -0.5),
        "conv_w": nrm(ks[4], (DEPTH, CONV_WIDTH, CONV_CH), CONV_WIDTH ** -0.5),
        "conv_b": nrm(ks[5], (DEPTH, CONV_CH), 0.02),
        "conv_ln_g": gain(ks[6], (DEPTH, CONV_CH)),
        "conv_ln_b": nrm(ks[7], (DEPTH, CONV_CH), 0.02),
        "sconv_w": nrm(ks[8], (DEPTH, SCONV_WIDTH, SCONV_CH), SCONV_WIDTH ** -0.5),
        "attn_sinks": nrm(ks[9], (DEPTH, N_Q_HEADS), 0.5),
        "pool_w": nrm(ks[10], (DEPTH, len(POOL_WINDOWS), POOL_GROUP, POOL_GROUP), POOL_GROUP ** -0.5),
        "pool_scale": gain(ks[11], (DEPTH, POOL_CH)),
        "mix_gain": gain(ks[12], (DEPTH, D_MODEL)),
        "w_out": nrm(ks[13], (DEPTH, D_MODEL, D_MODEL), D_MODEL ** -0.5),
        "norm_mlp": gain(ks[14], (DEPTH, D_MODEL)),
        "w_up": nrm(ks[15], (DEPTH, D_MODEL, D_FF), D_MODEL ** -0.5),
        "w_down": nrm(ks[16], (DEPTH, D_FF, D_MODEL), D_FF ** -0.5),
        "w_ple_gate": nrm(ks[17], (DEPTH, D_MODEL, D_MODEL), D_MODEL ** -0.5),
        "w_ple_proj": nrm(ks[18], (DEPTH, PLE_DIM, D_MODEL), PLE_DIM ** -0.5),
        "norm_final": gain(ks[19], (D_MODEL,)),
    }


def reference(x, p, norm_mix, w_in, conv_w, conv_b, conv_ln_g, conv_ln_b, sconv_w,
              attn_sinks, pool_w, pool_scale, mix_gain, w_out, norm_mlp, w_up, w_down,
              w_ple_gate, w_ple_proj, norm_final):
    h = x
    for i in range(DEPTH):
        hn = rmsnorm(h, norm_mix[i])
        proj = jnp.einsum("bsd,dc->bsc", hn, w_in[i])
        za, zb, zq, zk, zv, zd = jnp.split(proj, SPLIT_POINTS, axis=-1)
        ya = conformer_conv(za, conv_w[i], conv_b[i], conv_ln_g[i], conv_ln_b[i])
        yb = short_gated_conv(zb, sconv_w[i])
        yc = sliding_window_attention(zq, zk, zv, attn_sinks[i])
        yd = multiscale_pool(zd, pool_w[i], pool_scale[i])
        y = jnp.concatenate([rms_scale(ya), rms_scale(yb), rms_scale(yc), rms_scale(yd)],
                            axis=-1) * mix_gain[i]
        h = h + jnp.einsum("bsc,cd->bsd", y, w_out[i])
        hn = rmsnorm(h, norm_mlp[i])
        up = jnp.square(jax.nn.relu(jnp.einsum("bsd,df->bsf", hn, w_up[i])))
        h = h + jnp.einsum("bsf,fd->bsd", up, w_down[i])
        gate = jax.nn.sigmoid(jnp.einsum("bsd,de->bse", h, w_ple_gate[i]))
        h = h + gate * jnp.einsum("bsk,kd->bsd", p[i], w_ple_proj[i])
    return rmsnorm(h, norm_final)
```

```cpp
#include <hip/hip_runtime.h>
#include <cstdio>
#include <cstdint>
namespace pg8 {
#define PG8_LAS __attribute__((address_space(3)))
typedef unsigned short bf16_t;
typedef short bf16x8 __attribute__((ext_vector_type(8)));
typedef float f32x4 __attribute__((ext_vector_type(4)));
typedef unsigned u32x4 __attribute__((ext_vector_type(4)));
constexpr int BM = 256, BK = 64, HALF = 128, HTB = HALF * BK * 2  , STAGE_BYTES = 8 * HTB, NXCD = 8, WGM = 8;

__host__ __device__ __forceinline__ int lds_byte(int r, int c) { const int st = (r >> 4) * 2 + (c >> 5), rr = r & 15, cc = c & 31, ob = rr * 64 + cc * 2; return st * 1024 + (ob ^ (((ob >> 9) & 1) << 5)); }
__host__ __device__ __forceinline__ void stage_rc(int b, int& R, int& C) { const int st = b / 1024, sb = b % 1024, swz = sb ^ (((sb >> 9) & 1) << 5); R = (st >> 1) * 16 + swz / 64; C = (st & 1) * 32 + (swz % 64) / 2; }
__host__ __device__ __forceinline__ int perm32(int rho) { const int n = rho >> 4, i = rho & 15; return 8 * (i >> 2) + 4 * n + (i & 3); }

struct Unit { int pm, pn; };
struct Gemm { const bf16_t* A; const bf16_t* Bt; int M, N, K; };

struct StaticOrder {
    int nM, nN, nwg, G, c;
    __host__ __device__ void init(int M, int N, int G_, int c_) { nM = M / BM; nN = N / BM; nwg = nM * nN; G = G_; c = c_; }
    __host__ __device__ bool next(int i, Unit& u) const {
        const long L = (long)i * G + c; if (L >= nwg) return false;
        int wgid = (int)L; { const int q = nwg / NXCD, r = nwg % NXCD, xcd = wgid % NXCD, off = wgid / NXCD; wgid = (xcd < r ? xcd * (q + 1) : r * (q + 1) + (xcd - r) * q) + off; }
        const int nig = WGM * nN, gid = wgid / nig, fm = gid * WGM, gsz = (nM - fm) < WGM ? (nM - fm) : WGM;
        u.pm = fm + ((wgid % nig) % gsz); u.pn = (wgid % nig) / gsz; return true;
    }
    __device__ __forceinline__ void a_ready(const Unit&) const {}
    __device__ __forceinline__ void done(const Unit&) const {}
};
__device__ __forceinline__ unsigned cvt_pk_bf16(float lo, float hi) { unsigned r; asm volatile("v_cvt_pk_bf16_f32 %0, %1, %2" : "=v"(r) : "v"(lo), "v"(hi)); return r; }
typedef float f32x2 __attribute__((ext_vector_type(2)));
template <int ACT  > struct EpiBf16 {
    static constexpr bool PERM = true, AFTER_DRAIN = false;
    bf16_t* O; int ldc;
    __device__ __forceinline__ void operator()(const f32x4 (&acc)[2][2][4][2], const Unit& u, int wr, int wc, int fr, int fq) const {
        const int row0 = u.pm * BM + wr * 64 + fr, col0 = u.pn * BM + wc * 32 + 8 * fq;
#pragma unroll
        for (int ai = 0; ai < 2; ++ai)
#pragma unroll
            for (int m = 0; m < 4; ++m) { bf16_t* rowp = O + (size_t)(row0 + ai * HALF + m * 16) * ldc + col0;
#pragma unroll
                for (int bj = 0; bj < 2; ++bj) { f32x4 v0 = acc[ai][bj][m][0], v1 = acc[ai][bj][m][1];
                    if (ACT == 2) {
#pragma unroll
                        for (int e = 0; e < 4; ++e) { float a = v0[e] > 0.f ? v0[e] : 0.f; v0[e] = a * a; float b = v1[e] > 0.f ? v1[e] : 0.f; v1[e] = b * b; } }
                    u32x4 w; w.x = cvt_pk_bf16(v0[0], v0[1]); w.y = cvt_pk_bf16(v0[2], v0[3]); w.z = cvt_pk_bf16(v1[0], v1[1]); w.w = cvt_pk_bf16(v1[2], v1[3]);
                    *(u32x4*)(rowp + bj * HALF) = w; } }
    }
};
struct EpiRes {
    static constexpr bool PERM = true, AFTER_DRAIN = false;
    const float* res; float* out; bf16_t* hb; int ld;
    __device__ __forceinline__ void operator()(const f32x4 (&acc)[2][2][4][2], const Unit& u, int wr, int wc, int fr, int fq) const {
        const int row0 = u.pm * BM + wr * 64 + fr, col0 = u.pn * BM + wc * 32 + 8 * fq;
#pragma unroll
        for (int ai = 0; ai < 2; ++ai)
#pragma unroll
            for (int m = 0; m < 4; ++m) { const size_t off = (size_t)(row0 + ai * HALF + m * 16) * ld + col0;
#pragma unroll
                for (int bj = 0; bj < 2; ++bj) {
                    const f32x4 r0 = *(const f32x4*)(res + off + bj * HALF), r1 = *(const f32x4*)(res + off + bj * HALF + 4);
                    const f32x4 v0 = acc[ai][bj][m][0] + r0, v1 = acc[ai][bj][m][1] + r1;
                    *(f32x4*)(out + off + bj * HALF) = v0; *(f32x4*)(out + off + bj * HALF + 4) = v1;
                    if (hb) { u32x4 w; w.x = cvt_pk_bf16(v0[0], v0[1]); w.y = cvt_pk_bf16(v0[2], v0[3]); w.z = cvt_pk_bf16(v1[0], v1[1]); w.w = cvt_pk_bf16(v1[2], v1[3]);
                        *(u32x4*)(hb + off + bj * HALF) = w; } } }
    }
};
struct EpiGate {
    static constexpr bool PERM = true, AFTER_DRAIN = false;
    float* h; const bf16_t* pp; int ld;
    __device__ __forceinline__ void operator()(const f32x4 (&acc)[2][2][4][2], const Unit& u, int wr, int wc, int fr, int fq) const {
        const int row0 = u.pm * BM + wr * 64 + fr, col0 = u.pn * BM + wc * 32 + 8 * fq;
#pragma unroll
        for (int ai = 0; ai < 2; ++ai)
#pragma unroll
            for (int m = 0; m < 4; ++m) { const size_t off = (size_t)(row0 + ai * HALF + m * 16) * ld + col0;
#pragma unroll
                for (int bj = 0; bj < 2; ++bj) {
                    f32x4 r0 = *(const f32x4*)(h + off + bj * HALF), r1 = *(const f32x4*)(h + off + bj * HALF + 4);
                    const u32x4 pw = *(const u32x4*)(pp + off + bj * HALF);
                    const f32x4 a0 = acc[ai][bj][m][0], a1 = acc[ai][bj][m][1];
                    const unsigned pwv[4] = {pw.x, pw.y, pw.z, pw.w};
#pragma unroll
                    for (int e = 0; e < 4; ++e) {
                        const float p0 = __builtin_bit_cast(float, (e & 1) ? (pwv[e >> 1] & 0xffff0000u) : (pwv[e >> 1] << 16));
                        const float p1 = __builtin_bit_cast(float, (e & 1) ? (pwv[2 + (e >> 1)] & 0xffff0000u) : (pwv[2 + (e >> 1)] << 16));
                        r0[e] += p0 / (1.f + __expf(-a0[e])); r1[e] += p1 / (1.f + __expf(-a1[e])); }
                    *(f32x4*)(h + off + bj * HALF) = r0; *(f32x4*)(h + off + bj * HALF + 4) = r1; } }
    }
};
template <class Epi, class Sched, bool ALIGN_EPI = false, bool SP2 = false>
__device__ __forceinline__ void gemm_phase(PG8_LAS unsigned char* lds, const Gemm g, const Sched& S, const Epi& E, const int wave_in) {
    int lane; asm volatile("v_mbcnt_lo_u32_b32 %0, -1, 0\n\tv_mbcnt_hi_u32_b32 %0, -1, %0" : "=v"(lane));
    const int wid = wave_in, tid = wid * 64 + lane, wr = wid >> 2, wc = wid & 3, fr = lane & 15, fq = lane >> 4;
    const int K = g.K, nt = K / BK;
    unsigned voffA[2], voffB[2];
#pragma unroll
    for (int i = 0; i < 2; ++i) { int R, C; stage_rc(tid * 16 + i * 8192, R, C); const int Rb = Epi::PERM ? ((R & ~31) + perm32(R & 31)) : R;
        voffA[i] = (unsigned)(R * K + C) * 2u; voffB[i] = (unsigned)(Rb * K + C) * 2u; }
    const size_t kstep = (size_t)(BK * 2);
    const size_t hstep = (size_t)HALF * K * 2;
    const size_t tstep = 2 * hstep;
    const unsigned ldsw = (unsigned)wid * 1024u;
    const int aoff = lds_byte(wr * 64 + fr, fq * 8), boff = lds_byte(wc * 32 + fr, fq * 8);
#define PG8_SA(b, h) (((b) * 2 + (h)) * HTB)
#define PG8_SB(b, h) ((4 + (b) * 2 + (h)) * HTB)
#define PG8_STAGE(bufoff, gbase, voff) do { _Pragma("unroll") for (int _i = 0; _i < 2; ++_i) \
        __builtin_amdgcn_global_load_lds((const unsigned*)((const char*)(gbase) + (voff)[_i]), (PG8_LAS unsigned*)(lds + (bufoff) + ldsw + _i * 8192), 16, 0, 0); } while (0)
#define PG8_LDA(dst, b, h) do { _Pragma("unroll") for (int m = 0; m < 4; ++m) _Pragma("unroll") for (int k = 0; k < 2; ++k) dst[m][k] = *(const PG8_LAS bf16x8*)(lds + PG8_SA(b, h) + aoff + m * 2048 + k * 1024); } while (0)
#define PG8_LDB(dst, b, h) do { _Pragma("unroll") for (int n = 0; n < 2; ++n) _Pragma("unroll") for (int k = 0; k < 2; ++k) dst[n][k] = *(const PG8_LAS bf16x8*)(lds + PG8_SB(b, h) + boff + n * 2048 + k * 1024); } while (0)
#define PG8_MMA(ai, bj, At, Bt) do { __builtin_amdgcn_s_setprio(1); _Pragma("unroll") for (int m = 0; m < 4; ++m) _Pragma("unroll") for (int n = 0; n < 2; ++n) _Pragma("unroll") for (int k = 0; k < 2; ++k) \
        acc[ai][bj][m][n] = __builtin_amdgcn_mfma_f32_16x16x32_bf16(Bt[n][k], At[m][k], acc[ai][bj][m][n], 0, 0, 0); __builtin_amdgcn_s_setprio(0); } while (0)
#define PG8_WAIT_V(n) asm volatile("s_waitcnt vmcnt(" #n ")" ::: "memory")
#define PG8_WAIT_L(n) asm volatile("s_waitcnt lgkmcnt(" #n ")" ::: "memory")
#define PG8_BAR __builtin_amdgcn_s_barrier()
#define PG8_SCHED __builtin_amdgcn_sched_barrier(0)
    Unit cur, nxt; int ui = 0;
    if (!S.next(0, cur)) return;
    f32x4 acc[2][2][4][2];
#pragma unroll
    for (int a = 0; a < 2; ++a)
#pragma unroll
        for (int b = 0; b < 2; ++b)
#pragma unroll
            for (int m = 0; m < 4; ++m)
#pragma unroll
                for (int n = 0; n < 2; ++n) acc[a][b][m][n] = (f32x4){0.f, 0.f, 0.f, 0.f};
    bf16x8 At[4][2], B0[2][2], B1[2][2];
    const char* cA = (const char*)g.A + (size_t)cur.pm * tstep; const char* cB = (const char*)g.Bt + (size_t)cur.pn * tstep;
    S.a_ready(cur);
    if constexpr (SP2) {
        PG8_STAGE(PG8_SB(0, 0), cB, voffB); PG8_STAGE(PG8_SB(0, 1), cB + hstep, voffB); PG8_STAGE(PG8_SA(0, 0), cA, voffA); PG8_STAGE(PG8_SA(0, 1), cA + hstep, voffA);
        if (wr == 1) PG8_BAR;
        PG8_WAIT_V(2); PG8_BAR;
        PG8_STAGE(PG8_SB(1, 0), cB + kstep, voffB); PG8_STAGE(PG8_SA(1, 0), cA + kstep, voffA); PG8_STAGE(PG8_SB(1, 1), cB + hstep + kstep, voffB);
        PG8_WAIT_V(6); PG8_BAR;
    } else {
        PG8_STAGE(PG8_SB(0, 0), cB, voffB); PG8_STAGE(PG8_SA(0, 0), cA, voffA); PG8_STAGE(PG8_SB(0, 1), cB + hstep, voffB); PG8_STAGE(PG8_SA(0, 1), cA + hstep, voffA);
        if (wr == 1) PG8_BAR;
        PG8_WAIT_V(4); PG8_BAR;
        PG8_STAGE(PG8_SB(1, 0), cB + kstep, voffB); PG8_STAGE(PG8_SA(1, 0), cA + kstep, voffA); PG8_STAGE(PG8_SB(1, 1), cB + hstep + kstep, voffB);
        PG8_WAIT_V(6); PG8_BAR;
    }
    for (;;) {
        const bool has_next = S.next(ui + 1, nxt);
        const char* nA = has_next ? (const char*)g.A + (size_t)nxt.pm * tstep : cA; const char* nB = has_next ? (const char*)g.Bt + (size_t)nxt.pn * tstep : cB;
        for (int t = 0; t < nt; t += 2) {
            const bool last = (t == nt - 2);
            const char* a1 = cA + (size_t)(t + 1) * kstep;
            const char* a2 = last ? nA : cA + (size_t)(t + 2) * kstep; const char* b2 = last ? nB : cB + (size_t)(t + 2) * kstep;
            const char* a3 = a2 + kstep; const char* b3 = b2 + kstep;
            if (last && has_next) S.a_ready(nxt);
            if constexpr (SP2) {
            PG8_LDB(B0, 0, 0); PG8_LDB(B1, 0, 1); PG8_SCHED; PG8_LDA(At, 0, 0); PG8_STAGE(PG8_SA(1, 1), a1 + hstep, voffA);
            PG8_WAIT_V(8); PG8_WAIT_L(0); PG8_BAR; PG8_MMA(0, 0, At, B0); PG8_MMA(0, 1, At, B1); PG8_BAR; PG8_SCHED;
            PG8_LDA(At, 0, 1); PG8_STAGE(PG8_SB(0, 0), b2, voffB); PG8_STAGE(PG8_SB(0, 1), b2 + hstep, voffB); PG8_STAGE(PG8_SA(0, 0), a2, voffA);
            PG8_WAIT_V(8); PG8_WAIT_L(0); PG8_BAR; PG8_MMA(1, 0, At, B0); PG8_MMA(1, 1, At, B1); PG8_BAR; PG8_SCHED;
            PG8_LDB(B0, 1, 0); PG8_LDB(B1, 1, 1); PG8_SCHED; PG8_LDA(At, 1, 0); PG8_STAGE(PG8_SA(0, 1), a2 + hstep, voffA);
            PG8_WAIT_V(8); PG8_WAIT_L(0); PG8_BAR; PG8_MMA(0, 0, At, B0); PG8_MMA(0, 1, At, B1); PG8_BAR; PG8_SCHED;
            PG8_LDA(At, 1, 1); PG8_STAGE(PG8_SB(1, 0), b3, voffB); PG8_STAGE(PG8_SB(1, 1), b3 + hstep, voffB); PG8_STAGE(PG8_SA(1, 0), a3, voffA);
            PG8_WAIT_V(8); PG8_WAIT_L(0); PG8_BAR; PG8_MMA(1, 0, At, B0); PG8_MMA(1, 1, At, B1); PG8_BAR; PG8_SCHED;
            } else {
            PG8_LDB(B0, 0, 0); PG8_SCHED; PG8_LDA(At, 0, 0); PG8_STAGE(PG8_SA(1, 1), a1 + hstep, voffA);
            PG8_WAIT_L(8); PG8_BAR; PG8_WAIT_L(0); PG8_MMA(0, 0, At, B0); PG8_BAR; PG8_SCHED;
            PG8_LDB(B1, 0, 1); PG8_STAGE(PG8_SB(0, 0), b2, voffB);
            PG8_BAR; PG8_WAIT_L(0); PG8_MMA(0, 1, At, B1); PG8_BAR;
            PG8_LDA(At, 0, 1); PG8_STAGE(PG8_SA(0, 0), a2, voffA);
            PG8_BAR; PG8_WAIT_L(0); PG8_MMA(1, 0, At, B0); PG8_BAR; PG8_SCHED;
            PG8_STAGE(PG8_SB(0, 1), b2 + hstep, voffB);
            PG8_WAIT_V(6); PG8_BAR; PG8_MMA(1, 1, At, B1); PG8_BAR;
            PG8_LDB(B0, 1, 0); PG8_SCHED; PG8_LDA(At, 1, 0); PG8_STAGE(PG8_SA(0, 1), a2 + hstep, voffA);
            PG8_WAIT_L(8); PG8_BAR; PG8_WAIT_L(0); PG8_MMA(0, 0, At, B0); PG8_BAR; PG8_SCHED;
            PG8_LDB(B1, 1, 1); PG8_STAGE(PG8_SB(1, 0), b3, voffB);
            PG8_BAR; PG8_WAIT_L(0); PG8_MMA(0, 1, At, B1); PG8_BAR;
            PG8_LDA(At, 1, 1); PG8_STAGE(PG8_SA(1, 0), a3, voffA);
            PG8_BAR; PG8_WAIT_L(0); PG8_MMA(1, 0, At, B0); PG8_BAR; PG8_SCHED;
            PG8_STAGE(PG8_SB(1, 1), b3 + hstep, voffB);
            PG8_WAIT_V(6); PG8_BAR; PG8_MMA(1, 1, At, B1); PG8_BAR;
            }
        }
        if constexpr (ALIGN_EPI) { if (wr == 0) PG8_BAR; }
        if constexpr (!Epi::AFTER_DRAIN) { E(acc, cur, wr, wc, fr, fq); S.done(cur); }
        if (!has_next) break;
#pragma unroll
        for (int a = 0; a < 2; ++a)
#pragma unroll
            for (int b = 0; b < 2; ++b)
#pragma unroll
                for (int m = 0; m < 4; ++m)
#pragma unroll
                    for (int n = 0; n < 2; ++n) acc[a][b][m][n] = (f32x4){0.f, 0.f, 0.f, 0.f};
        cur = nxt; cA = nA; cB = nB; ++ui;
        if constexpr (ALIGN_EPI) { if (wr == 1) PG8_BAR; }
    }
    PG8_WAIT_V(0);
    if constexpr (!ALIGN_EPI) { if (wr == 0) PG8_BAR; }
    PG8_BAR;
    if constexpr (Epi::AFTER_DRAIN) { E.fused(acc, cur, wr, wc, fr, fq, lds, wid, lane); S.done(cur); }
#undef PG8_SA
#undef PG8_SB
#undef PG8_STAGE
#undef PG8_LDA
#undef PG8_LDB
#undef PG8_MMA
#undef PG8_WAIT_V
#undef PG8_WAIT_L
#undef PG8_BAR
#undef PG8_SCHED
}
}
#define GAS __attribute__((address_space(1)))
#define LAS __attribute__((address_space(3)))
typedef unsigned short bf16;
typedef unsigned v4u __attribute__((ext_vector_type(4)));
typedef float f32x4 __attribute__((ext_vector_type(4)));
typedef short bf16x8 __attribute__((ext_vector_type(8)));
typedef GAS unsigned gu32;
typedef GAS unsigned long long gu64;
#define RLX_AGENT __ATOMIC_RELAXED, __HIP_MEMORY_SCOPE_AGENT
#define LDS_WAIT() asm volatile("s_waitcnt lgkmcnt(0)" ::: "memory")
#define VM_WAIT() asm volatile("s_waitcnt vmcnt(0)" ::: "memory")
__device__ __forceinline__ unsigned long long rt() { return __builtin_amdgcn_s_memrealtime(); }
__device__ __forceinline__ unsigned f2bf(float f) { unsigned u = __builtin_bit_cast(unsigned, f); return (u + 0x7fffu + ((u >> 16) & 1u)) >> 16; }
__device__ __forceinline__ unsigned pk2(float lo, float hi) { return f2bf(lo) | (f2bf(hi) << 16); }
#define XB_TMO      128
#define XB_XCNT(j)  (256  + 64 * (j))
#define XB_XSUB(j)  (1280 + 64 * (j))
#define XB_XGEN(j)  (2304 + 64 * (j))
#define XB_TOP      3328
#define XB_TOPGEN   3392
#define XCD_BAR_WORDS 3456
#define XB_SPIN_CAP (1u << 18)

__device__ __forceinline__ unsigned xb_ld(unsigned* p)              { return __hip_atomic_load(p, __ATOMIC_RELAXED, __HIP_MEMORY_SCOPE_AGENT); }
__device__ __forceinline__ unsigned xb_add(unsigned* p, unsigned v) { return __hip_atomic_fetch_add(p, v, __ATOMIC_RELAXED, __HIP_MEMORY_SCOPE_AGENT); }
__device__ __forceinline__ unsigned xb_xcc_id() { return (unsigned)__builtin_amdgcn_s_getreg((3 << 11) | 20) & 0xFu; }
#define XB_SPIN(cond, bar) do { unsigned _sp = 0; while (cond) { __builtin_amdgcn_s_sleep(1); \
    if ((++_sp & 255u) == 0u) { if (xb_ld(&(bar)[XB_TMO])) break; if (_sp > XB_SPIN_CAP) { atomicAdd(&(bar)[XB_TMO], 1u); break; } } } } while (0)

struct XcdBarrier {
    unsigned* bar; unsigned x;
    volatile LAS unsigned* st;
};

__device__ __forceinline__ XcdBarrier xcd_barrier_post(unsigned* bar, volatile LAS unsigned* st) {
    XcdBarrier b; b.bar = bar; b.x = xb_xcc_id(); b.st = st;
    if (threadIdx.x == 0) (void)xb_add(&bar[XB_XCNT(b.x)], 1u);
    return b;
}
__device__ __forceinline__ void xcd_barrier_complete(unsigned* bar, unsigned x, unsigned& nloc, unsigned& nx) {
    const unsigned G = gridDim.x * gridDim.y * gridDim.z;
    unsigned sum, cnt, mine, sp = 0u;
    for (;;) {
        sum = 0u; cnt = 0u; mine = 0u;
#pragma unroll
        for (unsigned j = 0; j < 16; ++j) { const unsigned c = xb_ld(&bar[XB_XCNT(j)]); sum += c; cnt += (c > 0u) ? 1u : 0u; mine = (j == x) ? c : mine; }
        if (sum == G) break;
        __builtin_amdgcn_s_sleep(1);
        if ((++sp & 255u) == 0u) { if (xb_ld(&bar[XB_TMO])) break; if (sp > XB_SPIN_CAP) { atomicAdd(&bar[XB_TMO], 1u); break; } }
    }
    nloc = mine > 0u ? mine : 1u; nx = cnt > 0u ? cnt : 1u;
}

__device__ __forceinline__ void xcd_barrier(const XcdBarrier& b, const bool is_t0) {
    asm volatile("s_waitcnt vmcnt(0)" ::: "memory");
    __syncthreads();
    if (is_t0) {
        unsigned* bar = b.bar;
        __builtin_amdgcn_s_waitcnt(0);
        unsigned nloc = b.st[0], nx = b.st[1];
        if (nloc == 0u) { xcd_barrier_complete(bar, b.x, nloc, nx); b.st[0] = nloc; b.st[1] = nx; }
        const unsigned old = xb_add(&bar[XB_XSUB(b.x)], 1u);
        const unsigned gen = old / nloc;
        if (old + 1u == (gen + 1u) * nloc) {
            __builtin_amdgcn_fence(__ATOMIC_RELEASE, "agent");
            asm volatile("s_waitcnt vmcnt(0)" ::: "memory");
            const unsigned og = xb_add(&bar[XB_TOP], 1u);
            const unsigned tg = og / nx;
            if (og + 1u == (tg + 1u) * nx) xb_add(&bar[XB_TOPGEN], 1u);
            else XB_SPIN(xb_ld(&bar[XB_TOPGEN]) == tg, bar);
            __builtin_amdgcn_fence(__ATOMIC_ACQUIRE, "agent");
            xb_add(&bar[XB_XGEN(b.x)], 1u);
            asm volatile("s_waitcnt vmcnt(0)" ::: "memory");
        } else {
            XB_SPIN(xb_ld(&bar[XB_XGEN(b.x)]) == gen, bar);
            __builtin_amdgcn_fence(__ATOMIC_ACQUIRE, "agent");
            asm volatile("s_waitcnt vmcnt(0)" ::: "memory");
        }
    }
    __syncthreads();
}
typedef unsigned v2u __attribute__((ext_vector_type(2)));
#ifndef MK_N_LAUNCHES
#define MK_N_LAUNCHES 1
#endif
constexpr int NWAVES = 8;
constexpr int BATCH = 2, SEQ = 8192, DM = 4096, M = BATCH * SEQ, INC = 7424, FF = 16384, PLE = 256, DEPTH = 2;
constexpr int C_AV = 0, C_AG = 1024, C_BG = 2048, C_CG = 3072, C_BX = 4096, C_Q = 5120, C_K = 6144, C_V = 6272, C_D = 6400;
constexpr float EPS = 1e-6f;
constexpr int N_PHASES = 18;
constexpr size_t MiB = 1u << 20;
constexpr size_t WS_CTL = 0, CTL_ZERO_BYTES = 1 * MiB;
constexpr size_t WS_W = 2 * MiB, W_LAYER = 388 * MiB;
constexpr size_t WO_IN = 0, WO_OUT = 58 * MiB, WO_UP = 90 * MiB, WO_DOWN = 218 * MiB, WO_G = 346 * MiB, WO_P = 378 * MiB, WO_PB = 380 * MiB;
constexpr size_t WS_H = 780 * MiB, WS_XN = 1036 * MiB, WS_PP = 1164 * MiB, WS_BIG = 1292 * MiB, WS_Y = WS_BIG + 232 * MiB, WS_END = 1804 * MiB;
constexpr int CW_BAR = 4096;
constexpr size_t WS_CWT = 1 * MiB;
constexpr int RING_BYTES = 131072, LDSCTL_OFF = RING_BYTES, MISC_OFF = LDSCTL_OFF + 320, LDS_BYTES = 147456;

struct Frame {
    LAS unsigned char* lds;
    volatile LAS unsigned* MISC;
    gu32* ctl;
    int wave, vcu, G;
};
__device__ __forceinline__ int fresh_lane() { int l; asm volatile("v_mbcnt_lo_u32_b32 %0, -1, 0\n\tv_mbcnt_hi_u32_b32 %0, -1, %0" : "=v"(l)); return l; }

__device__ __forceinline__ float wave_sum(float v) {
#pragma unroll
    for (int o = 1; o < 64; o <<= 1) v += __shfl_xor(v, o);
    return v;
}
__device__ __forceinline__ float bf2f(bf16 u) { return __builtin_bit_cast(float, (unsigned)u << 16); }
__device__ __forceinline__ float bflo(unsigned w) { return __builtin_bit_cast(float, w << 16); }
__device__ __forceinline__ float bfhi(unsigned w) { return __builtin_bit_cast(float, w & 0xffff0000u); }

__device__ __forceinline__ void tr_item(const float* W, int K, int ldw, int nblk, bf16* WT, LAS float* scr, int item, int lane) {
    const int kb = item / nblk, nb = item - kb * nblk, k0 = 64 * kb, n0 = 32 * nb;
#pragma unroll 8
    for (int i = 0; i < 32; ++i) { const int kk = 2 * i + (lane >> 5); scr[kk * 33 + (lane & 31)] = W[(size_t)(k0 + kk) * ldw + n0 + (lane & 31)]; }
    LDS_WAIT(); asm volatile("" ::: "memory");
    const int c = lane & 7;
#pragma unroll
    for (int j = 0; j < 4; ++j) { const int n = (lane >> 3) + 8 * j; const LAS float* s = scr + (8 * c) * 33 + n;
        v4u o; o.x = pk2(s[0 * 33], s[1 * 33]); o.y = pk2(s[2 * 33], s[3 * 33]); o.z = pk2(s[4 * 33], s[5 * 33]); o.w = pk2(s[6 * 33], s[7 * 33]);
        *(GAS v4u*)(WT + (size_t)(n0 + n) * K + k0 + 8 * c) = o; }
    LDS_WAIT(); asm volatile("" ::: "memory");
}
struct ProIn { const float *p, *w_in, *pool_w, *w_out, *w_up, *w_down, *w_g, *w_p, *conv_w; unsigned char* ws; };
__device__ __forceinline__ void prologue(Frame& F, const ProIn& I) {
    const int lane_ = fresh_lane();
    LAS float* scr = (LAS float*)(F.lds + F.wave * 16384);
    const int gw = F.vcu * NWAVES + F.wave, NGW = F.G * NWAVES;
    constexpr int I_IN = 64 * 200, I_OUT = 64 * 128, I_UP = 64 * 512, I_DOWN = 256 * 128, I_G = 64 * 128, I_P = 4 * 128;
    constexpr int I_LAYER = I_IN + I_OUT + I_UP + I_DOWN + I_G + I_P;
    for (int it = gw; it < DEPTH * I_LAYER; it += NGW) {
        const int L = it / I_LAYER; int r = it - L * I_LAYER;
        unsigned char* wl = I.ws + WS_W + (size_t)L * W_LAYER;
        if (r < I_IN) { tr_item(I.w_in + (size_t)L * DM * INC, DM, INC, 200, (bf16*)(wl + WO_IN), scr, r, lane_); continue; } r -= I_IN;
        if (r < I_OUT) { tr_item(I.w_out + (size_t)L * DM * DM, DM, DM, 128, (bf16*)(wl + WO_OUT), scr, r, lane_); continue; } r -= I_OUT;
        if (r < I_UP) { tr_item(I.w_up + (size_t)L * DM * FF, DM, FF, 512, (bf16*)(wl + WO_UP), scr, r, lane_); continue; } r -= I_UP;
        if (r < I_DOWN) { tr_item(I.w_down + (size_t)L * FF * DM, FF, DM, 128, (bf16*)(wl + WO_DOWN), scr, r, lane_); continue; } r -= I_DOWN;
        if (r < I_G) { tr_item(I.w_g + (size_t)L * DM * DM, DM, DM, 128, (bf16*)(wl + WO_G), scr, r, lane_); continue; } r -= I_G;
        tr_item(I.w_p + (size_t)L * PLE * DM, PLE, DM, 128, (bf16*)(wl + WO_P), scr, r, lane_);
    }
    for (int it = gw; it < DEPTH * 2048; it += NGW) {
        const int L = it >> 11, r = it & 2047, kblk = r & 63, g = (r >> 6) & 3, dch = r >> 8;
        const int k = kblk * 64 + lane_;
        const float* a = I.w_in + (size_t)L * DM * INC + (size_t)k * INC + C_D + g * 256;
        const float* pw = I.pool_w + (size_t)L * 4 * 65536 + (size_t)g * 65536 + dch * 32;
        float acc[32];
#pragma unroll
        for (int d = 0; d < 32; ++d) acc[d] = 0.f;
#pragma unroll 2
        for (int c = 0; c < 256; ++c) { const float av = a[c];
#pragma unroll
            for (int d = 0; d < 32; ++d) acc[d] += av * pw[c * 256 + d]; }
        bf16* o = (bf16*)(I.ws + WS_W + (size_t)L * W_LAYER + WO_IN) + (size_t)(C_D + g * 256 + dch * 32) * DM + k;
#pragma unroll
        for (int d = 0; d < 32; ++d) o[(size_t)d * DM] = (bf16)f2bf(acc[d]);
    }
    for (int e = gw * 64 + lane_; e < DEPTH * 1024 * 32; e += NGW * 64) { const int L = e >> 15, c = (e >> 5) & 1023, k = e & 31;
        ((float*)(I.ws + WS_CWT))[e] = (k < 31) ? I.conv_w[(size_t)L * 31 * 1024 + k * 1024 + c] : 0.f; }
    for (int ch = gw * 64 + lane_; ch < DEPTH * M * PLE / 8; ch += NGW * 64) {
        const int L = ch / (M * PLE / 8), r = ch - L * (M * PLE / 8);
        const f32x4 a = ((const f32x4*)I.p)[2 * (size_t)ch], b = ((const f32x4*)I.p)[2 * (size_t)ch + 1];
        v4u o; o.x = pk2(a.x, a.y); o.y = pk2(a.z, a.w); o.z = pk2(b.x, b.y); o.w = pk2(b.z, b.w);
        ((v4u*)(I.ws + WS_W + (size_t)L * W_LAYER + WO_PB))[r] = o;
    }
}

__device__ __forceinline__ void norm_phase(Frame& F, const float* src, const float* g, bf16* dst_bf, float* dst_f) {
    const int lane_ = fresh_lane();
    const int gw = F.vcu * NWAVES + F.wave, NGW = F.G * NWAVES;
    for (int m = gw; m < M; m += NGW) {
        const f32x4* xr = (const f32x4*)(src + (size_t)m * DM) + lane_;
        f32x4 v[16]; float s = 0.f;
#pragma unroll
        for (int j = 0; j < 16; ++j) { v[j] = xr[64 * j]; s += (v[j].x * v[j].x + v[j].y * v[j].y) + (v[j].z * v[j].z + v[j].w * v[j].w); }
        const float rstd = 1.f / sqrtf(wave_sum(s) * (1.f / DM) + EPS);
        const f32x4* gr = (const f32x4*)g + lane_;
        if (dst_bf) { unsigned long long* o8 = (unsigned long long*)(dst_bf + (size_t)m * DM) + lane_;
#pragma unroll
            for (int j = 0; j < 16; ++j) { const f32x4 gv = gr[64 * j];
                o8[64 * j] = (unsigned long long)pk2(v[j].x * rstd * gv.x, v[j].y * rstd * gv.y) | ((unsigned long long)pk2(v[j].z * rstd * gv.z, v[j].w * rstd * gv.w) << 32); } }
        else { f32x4* o = (f32x4*)(dst_f + (size_t)m * DM) + lane_;
#pragma unroll
            for (int j = 0; j < 16; ++j) { const f32x4 gv = gr[64 * j]; o[64 * j] = (f32x4){v[j].x * rstd * gv.x, v[j].y * rstd * gv.y, v[j].z * rstd * gv.z, v[j].w * rstd * gv.w}; } }
    }
}

struct MixP { const bf16* proj; bf16* Y; const float *conv_wt, *conv_b, *ln_g, *ln_b, *sconv_w, *sinks, *pool_scale, *gain; };

template <int N> __device__ __forceinline__ void block_reduce(float (&v)[N], LAS float* red, int wave, int lane, int tid) {
#pragma unroll
    for (int i = 0; i < N; ++i) v[i] = wave_sum(v[i]);
    if (lane == 0) {
#pragma unroll
        for (int i = 0; i < N; ++i) red[wave * N + i] = v[i]; }
    __syncthreads();
    if (tid < N) { float s = 0.f;
#pragma unroll
        for (int w = 0; w < NWAVES; ++w) s += red[w * N + tid];
        red[NWAVES * N + tid] = s; }
    __syncthreads();
#pragma unroll
    for (int i = 0; i < N; ++i) v[i] = red[NWAVES * N + i];
    __syncthreads();
}

__device__ __forceinline__ void stage_rows(const bf16* pj, int t_first, int nrows, int col0, LAS bf16* dst, int tid) {
#pragma unroll 4
    for (int it = tid; it < nrows * 128; it += NWAVES * 64) { const int r = it >> 7, ch = (it & 127) * 8; const int t = t_first + r;
        v4u v = (v4u){0u, 0u, 0u, 0u};
        if (t >= 0) v = *(const v4u*)(pj + (size_t)t * INC + col0 + ch);
        *(LAS v4u*)(dst + r * 1024 + ch) = v; }
}
__device__ __forceinline__ float glu1(float val, float gt) { return val / (1.f + __expf(-gt)); }
__device__ __forceinline__ void mix_abd_tile(Frame& F, const MixP& P, int tile, LAS unsigned char* lds) {
    const int lane = fresh_lane(), wave = F.wave, tid = wave * 64 + lane;
    const int b = tile >> 9, t0 = (tile & 511) * 16;
    const bf16* pj = P.proj + (size_t)b * SEQ * INC;
    bf16* yo = P.Y + ((size_t)b * SEQ + t0) * DM;
    LAS bf16* L0 = (LAS bf16*)lds;
    LAS float* red = (LAS float*)(lds + 120 * 1024);
    {
#pragma unroll 2
        for (int it = tid; it < 46 * 128; it += NWAVES * 64) { const int r = it >> 7, ch = (it & 127) * 8; const int t = t0 - 30 + r;
            v4u o = (v4u){0u, 0u, 0u, 0u};
            if (t >= 0) { const bf16* row = pj + (size_t)t * INC + ch; const v4u va = *(const v4u*)(row + C_AV), vg = *(const v4u*)(row + C_AG);
                o.x = pk2(glu1(bflo(va.x), bflo(vg.x)), glu1(bfhi(va.x), bfhi(vg.x))); o.y = pk2(glu1(bflo(va.y), bflo(vg.y)), glu1(bfhi(va.y), bfhi(vg.y)));
                o.z = pk2(glu1(bflo(va.z), bflo(vg.z)), glu1(bfhi(va.z), bfhi(vg.z))); o.w = pk2(glu1(bflo(va.w), bflo(vg.w)), glu1(bfhi(va.w), bfhi(vg.w))); }
            *(LAS v4u*)(L0 + r * 1024 + ch) = o; }
        __syncthreads();
        float ya[2][16], st[32];
#pragma unroll
        for (int i = 0; i < 32; ++i) st[i] = 0.f;
#pragma unroll
        for (int cc = 0; cc < 2; ++cc) { const int c = tid + 512 * cc;
            float w[32];
            const f32x4* wp = (const f32x4*)(P.conv_wt + (size_t)c * 32);
#pragma unroll
            for (int k = 0; k < 8; ++k) { const f32x4 v = wp[k]; w[4 * k] = v.x; w[4 * k + 1] = v.y; w[4 * k + 2] = v.z; w[4 * k + 3] = v.w; }
            const float bias = P.conv_b[c];
            float a[16];
#pragma unroll
            for (int i = 0; i < 16; ++i) a[i] = bias;
            const LAS bf16* up = L0 + c;
#pragma unroll
            for (int j = 0; j < 46; ++j) { const float uv = bf2f(up[j * 1024]);
#pragma unroll
                for (int i = 0; i < 16; ++i) if (j - i >= 0 && j - i <= 30) a[i] += w[j - i] * uv; }
#pragma unroll
            for (int i = 0; i < 16; ++i) { ya[cc][i] = a[i]; st[i] += a[i]; st[16 + i] += a[i] * a[i]; } }
        block_reduce<32>(st, red, wave, lane, tid);
        float s2[16];
#pragma unroll
        for (int i = 0; i < 16; ++i) { const float mean = st[i] * (1.f / 1024.f); float var = st[16 + i] * (1.f / 1024.f) - mean * mean; var = var > 0.f ? var : 0.f;
            st[i] = mean; st[16 + i] = 1.f / sqrtf(var + EPS); s2[i] = 0.f; }
#pragma unroll
        for (int cc = 0; cc < 2; ++cc) { const int c = tid + 512 * cc; const float g = P.ln_g[c], bb = P.ln_b[c];
#pragma unroll
            for (int i = 0; i < 16; ++i) { const float x = (ya[cc][i] - st[i]) * st[16 + i] * g + bb; const float s = x / (1.f + __expf(-x)); ya[cc][i] = s; s2[i] += s * s; } }
        block_reduce<16>(s2, red, wave, lane, tid);
#pragma unroll
        for (int i = 0; i < 16; ++i) s2[i] = 1.f / sqrtf(s2[i] * (1.f / 1024.f) + EPS);
#pragma unroll
        for (int cc = 0; cc < 2; ++cc) { const int c = tid + 512 * cc; const float gn = P.gain[c]; bf16* yp = yo + c;
#pragma unroll 1
            for (int i = 0; i < 16; ++i) { float v = ya[cc][0] * s2[0];
#pragma unroll
                for (int q = 1; q < 16; ++q) v = (i == q) ? ya[cc][q] * s2[q] : v;
                yp[(size_t)i * DM] = (bf16)f2bf(v * gn); } }
    }
    {
        LAS bf16* Lcg = L0, *Lx = L0 + 18 * 1024, *Lbg = L0 + 36 * 1024;
        stage_rows(pj, t0 - 2, 18, C_CG, Lcg, tid); stage_rows(pj, t0 - 2, 18, C_BX, Lx, tid); stage_rows(pj, t0, 16, C_BG, Lbg, tid);
        __syncthreads();
        float yb[2][16], s2[16];
#pragma unroll
        for (int i = 0; i < 16; ++i) s2[i] = 0.f;
#pragma unroll
        for (int cc = 0; cc < 2; ++cc) { const int c = tid + 512 * cc;
            const float w0 = P.sconv_w[c], w1 = P.sconv_w[1024 + c], w2 = P.sconv_w[2048 + c];
            float g[18];
#pragma unroll
            for (int j = 0; j < 18; ++j) g[j] = bf2f(Lcg[j * 1024 + c]) * bf2f(Lx[j * 1024 + c]);
#pragma unroll
            for (int i = 0; i < 16; ++i) { const float bg = bf2f(Lbg[i * 1024 + c]);
                const float v = bg * (w0 * g[i] + w1 * g[i + 1] + w2 * g[i + 2]); yb[cc][i] = v; s2[i] += v * v; } }
        block_reduce<16>(s2, red, wave, lane, tid);
#pragma unroll
        for (int i = 0; i < 16; ++i) s2[i] = 1.f / sqrtf(s2[i] * (1.f / 1024.f) + EPS);
#pragma unroll
        for (int cc = 0; cc < 2; ++cc) { const int c = tid + 512 * cc; const float gn = P.gain[1024 + c]; bf16* yp = yo + 1024 + c;
#pragma unroll 1
            for (int i = 0; i < 16; ++i) { float v = yb[cc][0] * s2[0];
#pragma unroll
                for (int q = 1; q < 16; ++q) v = (i == q) ? yb[cc][q] * s2[q] : v;
                yp[(size_t)i * DM] = (bf16)f2bf(v * gn); } }
    }
    {
        stage_rows(pj, t0 - 15, 31, C_D, L0, tid);
        __syncthreads();
        float yd[2][16], s2[16];
#pragma unroll
        for (int i = 0; i < 16; ++i) s2[i] = 0.f;
#pragma unroll
        for (int cc = 0; cc < 2; ++cc) { const int c = tid + 512 * cc; const int gi = (wave >> 2) + 2 * cc; const int w = 2 << gi; const float ps = P.pool_scale[c];
            float z[31];
#pragma unroll
            for (int j = 0; j < 31; ++j) z[j] = bf2f(L0[j * 1024 + c]);
#pragma unroll
            for (int i = 0; i < 16; ++i) { float s = 0.f;
#pragma unroll
                for (int m = 0; m < 16; ++m) if (m < w) s += z[15 + i - m];
                const int tt = t0 + i; const int cnt = (tt + 1 < w) ? (tt + 1) : w;
                const float v = (s / (float)cnt - z[15 + i]) * ps; yd[cc][i] = v; s2[i] += v * v; } }
        block_reduce<16>(s2, red, wave, lane, tid);
#pragma unroll
        for (int i = 0; i < 16; ++i) s2[i] = 1.f / sqrtf(s2[i] * (1.f / 1024.f) + EPS);
#pragma unroll
        for (int cc = 0; cc < 2; ++cc) { const int c = tid + 512 * cc; const float gn = P.gain[3072 + c]; bf16* yp = yo + 3072 + c;
#pragma unroll 1
            for (int i = 0; i < 16; ++i) { float v = yd[cc][0] * s2[0];
#pragma unroll
                for (int q = 1; q < 16; ++q) v = (i == q) ? yd[cc][q] * s2[q] : v;
                yp[(size_t)i * DM] = (bf16)f2bf(v * gn); } }
    }
}

__device__ __forceinline__ void mix_attn_tile(Frame& F, const MixP& P, int tile, LAS unsigned char* lds) {
    constexpr int KSP = 72, VTP = 200;
    LAS bf16* Ks = (LAS bf16*)lds;
    LAS bf16* Vt = (LAS bf16*)(lds + 55296);
    LAS float* ssq = (LAS float*)(lds + 55296 + 51200 + 256);
    LAS float* rsq = ssq + 1024;
    const int lane = fresh_lane(), wave = F.wave, tid = wave * 64 + lane;
    const int b = tile >> 7, t0 = (tile & 127) * 64;
    const bf16* pj = P.proj + (size_t)b * SEQ * INC;
    bf16* yo = P.Y + ((size_t)b * SEQ + t0) * DM + 2048;
#pragma unroll
    for (int r = 0; r < 6; ++r) { const int q = tid + 512 * r; const int kvh = q / 1536; const int rem = q - kvh * 1536; const int key = rem >> 3, dc = rem & 7; const int t = t0 - 128 + key;
        v4u kv = (v4u){0u, 0u, 0u, 0u}, vv = (v4u){0u, 0u, 0u, 0u};
        if (t >= 0) { const bf16* row = pj + (size_t)t * INC; kv = *(const v4u*)(row + C_K + kvh * 64 + dc * 8); vv = *(const v4u*)(row + C_V + kvh * 64 + dc * 8); }
        *(LAS v4u*)(Ks + (kvh * 192 + key) * KSP + dc * 8) = kv;
        const unsigned vw[4] = {vv.x, vv.y, vv.z, vv.w};
#pragma unroll
        for (int e = 0; e < 8; ++e) Vt[(kvh * 64 + dc * 8 + e) * VTP + key] = (bf16)((e & 1) ? (vw[e >> 1] >> 16) : (vw[e >> 1] & 0xffffu)); }
    __syncthreads();
    const int fr = lane & 15, fq = lane >> 4, kvh = wave >> 2;
#pragma unroll 1
    for (int hh = 0; hh < 2; ++hh) {
        const int head = wave * 2 + hh;
        const float slope = exp2f(-0.5f * (float)(head + 1)), sink = P.sinks[head];
#pragma unroll 1
        for (int qs = 0; qs < 4; ++qs) {
            const bf16* qrow = pj + (size_t)(t0 + 16 * qs + fr) * INC + C_Q + head * 64 + fq * 8;
            const bf16x8 q0 = *(const bf16x8*)qrow, q1 = *(const bf16x8*)(qrow + 32);
            f32x4 s[9];
#pragma unroll
            for (int j = 0; j < 9; ++j) { const LAS bf16* kp = Ks + (kvh * 192 + (qs + j) * 16 + fr) * KSP + fq * 8;
                const bf16x8 k0 = *(const LAS bf16x8*)kp, k1 = *(const LAS bf16x8*)(kp + 32);
                f32x4 a = (f32x4){0.f, 0.f, 0.f, 0.f};
                a = __builtin_amdgcn_mfma_f32_16x16x32_bf16(k0, q0, a, 0, 0, 0); a = __builtin_amdgcn_mfma_f32_16x16x32_bf16(k1, q1, a, 0, 0, 0); s[j] = a; }
            float mx = -3.0e38f;
#pragma unroll
            for (int j = 0; j < 9; ++j)
#pragma unroll
                for (int i = 0; i < 4; ++i) { const int dist = 128 + fr - 16 * j - 4 * fq - i; const int kr = (qs + j) * 16 + 4 * fq + i;
                    const bool valid = (dist >= 0) && (dist < 128) && (t0 - 128 + kr >= 0);
                    const float sc = valid ? (s[j][i] * 0.125f - slope * (float)dist) : -1e30f; s[j][i] = sc; mx = fmaxf(mx, sc); }
            mx = fmaxf(mx, __shfl_xor(mx, 16)); mx = fmaxf(mx, __shfl_xor(mx, 32));
            const float mm = fmaxf(mx, sink);
            float l = 0.f;
#pragma unroll
            for (int j = 0; j < 9; ++j)
#pragma unroll
                for (int i = 0; i < 4; ++i) { const float p = __expf(s[j][i] - mm); s[j][i] = p; l += p; }
            l += __shfl_xor(l, 16); l += __shfl_xor(l, 32);
            l += __expf(sink - mm);
            const float inv = 1.f / l;
            unsigned pk[9][2];
#pragma unroll
            for (int j = 0; j < 9; ++j) { pk[j][0] = pk2(s[j][0], s[j][1]); pk[j][1] = pk2(s[j][2], s[j][3]); }
            f32x4 o[4];
#pragma unroll
            for (int dt = 0; dt < 4; ++dt) o[dt] = (f32x4){0.f, 0.f, 0.f, 0.f};
#pragma unroll
            for (int kp = 0; kp < 5; ++kp) { const int j0 = 2 * kp, j1 = (kp == 4) ? 8 : 2 * kp + 1;
                v4u bw; bw.x = pk[j0][0]; bw.y = pk[j0][1]; bw.z = (kp == 4) ? 0u : pk[j1][0]; bw.w = (kp == 4) ? 0u : pk[j1][1];
                const bf16x8 bop = __builtin_bit_cast(bf16x8, bw);
#pragma unroll
                for (int dt = 0; dt < 4; ++dt) { const LAS bf16* vp = Vt + (kvh * 64 + dt * 16 + fr) * VTP + 4 * fq;
                    const v2u lo = *(const LAS v2u*)(vp + (qs + j0) * 16), hi = *(const LAS v2u*)(vp + (qs + j1) * 16);
                    const v4u aw = (v4u){lo.x, lo.y, hi.x, hi.y};
                    o[dt] = __builtin_amdgcn_mfma_f32_16x16x32_bf16(__builtin_bit_cast(bf16x8, aw), bop, o[dt], 0, 0, 0); } }
            float sq = 0.f;
#pragma unroll
            for (int dt = 0; dt < 4; ++dt) { o[dt] = o[dt] * inv; sq += (o[dt].x * o[dt].x + o[dt].y * o[dt].y) + (o[dt].z * o[dt].z + o[dt].w * o[dt].w);
                v2u w2; w2.x = pk2(o[dt].x, o[dt].y); w2.y = pk2(o[dt].z, o[dt].w);
                *(v2u*)(yo + (size_t)(16 * qs + fr) * DM + head * 64 + dt * 16 + 4 * fq) = w2; }
            sq += __shfl_xor(sq, 16); sq += __shfl_xor(sq, 32);
            if (fq == 0) ssq[head * 64 + 16 * qs + fr] = sq;
        }
    }
    __syncthreads();
    if (tid < 64) { float s = 0.f;
#pragma unroll
        for (int h = 0; h < 16; ++h) s += ssq[h * 64 + tid];
        rsq[tid] = 1.f / sqrtf(s * (1.f / 1024.f) + EPS); }
    __syncthreads();
#pragma unroll 4
    for (int r = 0; r < 16; ++r) { const int ch = tid + 512 * r; const int q = ch >> 7, cc = (ch & 127) * 8;
        bf16* p = yo + (size_t)q * DM + cc; const v4u w = *(const v4u*)p; const float rs = rsq[q];
        const f32x4 g0 = *(const f32x4*)(P.gain + 2048 + cc), g1 = *(const f32x4*)(P.gain + 2048 + cc + 4);
        v4u o; o.x = pk2(bflo(w.x) * rs * g0.x, bfhi(w.x) * rs * g0.y); o.y = pk2(bflo(w.y) * rs * g0.z, bfhi(w.y) * rs * g0.w);
        o.z = pk2(bflo(w.z) * rs * g1.x, bfhi(w.z) * rs * g1.y); o.w = pk2(bflo(w.w) * rs * g1.z, bfhi(w.w) * rs * g1.w);
        *(v4u*)p = o; }
    __syncthreads();
}

struct Args { const float* in[20]; float* out; unsigned char* ws; int ph_lo, ph_hi; };
typedef __attribute__((address_space(4))) const unsigned char* kargp;
__device__ __forceinline__ const float* INP(int i) { kargp k = (kargp)__builtin_amdgcn_kernarg_segment_ptr(); asm volatile("" : "+s"(k)); return (const float*)(*(__attribute__((address_space(4))) const unsigned long long*)(k + 8 * i)); }

__global__ void __launch_bounds__(NWAVES * 64, 2) mk_fwd(Args args) {
    extern __shared__ __attribute__((aligned(16))) unsigned char lds[];
    Frame F;
    F.lds = (LAS unsigned char*)lds;
    F.MISC = (volatile LAS unsigned*)(F.lds + MISC_OFF);
    F.wave = __builtin_amdgcn_readfirstlane((int)threadIdx.x >> 6);
    F.G = gridDim.x; { const int bx = blockIdx.x; F.vcu = (F.G % 8 == 0) ? (bx % 8) * (F.G / 8) + bx / 8 : bx; }
#define WS_ ((unsigned char*)INP(21))
#define H_ ((float*)(WS_ + WS_H))
#define XN_ ((bf16*)(WS_ + WS_XN))
#define PP_ ((bf16*)(WS_ + WS_PP))
#define PROJ_ ((bf16*)(WS_ + WS_BIG))
#define Y_ ((bf16*)(WS_ + WS_Y))
#define UP_ ((bf16*)(WS_ + WS_BIG))
#define WL_(L, off) ((const bf16*)(WS_ + WS_W + (size_t)(L) * W_LAYER + (off)))
    F.ctl = (gu32*)(WS_ + WS_CTL);
    for (int u = threadIdx.x; u < (LDS_BYTES - LDSCTL_OFF) / 4; u += NWAVES * 64) ((LAS unsigned*)(F.lds + LDSCTL_OFF))[u] = 0u;
    __syncthreads();
    const int lo = args.ph_lo, hi = args.ph_hi;
    if (hi - lo > 1) (void)xcd_barrier_post((unsigned*)(WS_ + WS_CTL) + CW_BAR, F.MISC + 8);
#define IN(k) (lo <= (k) && (k) < hi)
#define SEAM(k) do { if (IN(k) && IN((k) + 1)) { XcdBarrier b_; b_.bar = (unsigned*)(WS_ + WS_CTL) + CW_BAR; b_.x = xb_xcc_id(); b_.st = F.MISC + 8; xcd_barrier(b_, (F.wave == 0) && (fresh_lane() == 0)); } } while (0)

    if (IN(0)) { ProIn I{INP(1), INP(3), INP(10), INP(13), INP(15), INP(16), INP(17), INP(18), INP(4), WS_}; prologue(F, I); }
    SEAM(0);
#pragma unroll
    for (int L = 0; L < DEPTH; ++L) {
        const int pb = 1 + 8 * L;
        if (IN(pb + 0)) norm_phase(F, (L == 0) ? INP(0) : (const float*)H_, INP(2) + (size_t)L * DM, XN_, nullptr);
        SEAM(pb + 0);
        if (IN(pb + 1)) { pg8::Gemm g{XN_, WL_(L, WO_IN), M, INC, DM}; pg8::StaticOrder S; S.init(M, INC, F.G, (int)blockIdx.x);
            pg8::EpiBf16<0> E{PROJ_, INC}; pg8::gemm_phase<pg8::EpiBf16<0>, pg8::StaticOrder, true, true>(F.lds, g, S, E, F.wave); }
        SEAM(pb + 1);
        if (IN(pb + 2)) {
            MixP P{PROJ_, Y_, (const float*)(WS_ + WS_CWT) + (size_t)L * 32 * 1024, INP(5) + (size_t)L * 1024, INP(6) + (size_t)L * 1024, INP(7) + (size_t)L * 1024,
                   INP(8) + (size_t)L * 3 * 1024, INP(9) + (size_t)L * 16, INP(11) + (size_t)L * 1024, INP(12) + (size_t)L * DM};
            for (int tile = F.vcu; tile < BATCH * SEQ / 64; tile += F.G) mix_attn_tile(F, P, tile, F.lds);
            for (int tile = F.vcu; tile < BATCH * SEQ / 16; tile += F.G) mix_abd_tile(F, P, tile, F.lds);
        }
        SEAM(pb + 2);
        if (IN(pb + 3)) { pg8::Gemm g{Y_, WL_(L, WO_OUT), M, DM, DM}; pg8::StaticOrder S; S.init(M, DM, F.G, (int)blockIdx.x);
            pg8::EpiRes E{(L == 0) ? INP(0) : (const float*)H_, H_, nullptr, DM}; pg8::gemm_phase<pg8::EpiRes, pg8::StaticOrder, true, true>(F.lds, g, S, E, F.wave); }
        SEAM(pb + 3);
        if (IN(pb + 4)) norm_phase(F, H_, INP(14) + (size_t)L * DM, XN_, nullptr);
        SEAM(pb + 4);
        if (IN(pb + 5)) { pg8::Gemm g{XN_, WL_(L, WO_UP), M, FF, DM}; pg8::StaticOrder S; S.init(M, FF, F.G, (int)blockIdx.x);
            pg8::EpiBf16<2> E{UP_, FF}; pg8::gemm_phase<pg8::EpiBf16<2>, pg8::StaticOrder, true, true>(F.lds, g, S, E, F.wave); }
        SEAM(pb + 5);
        if (IN(pb + 6)) {
            { pg8::Gemm g{UP_, WL_(L, WO_DOWN), M, DM, FF}; pg8::StaticOrder S; S.init(M, DM, F.G, (int)blockIdx.x);
              pg8::EpiRes E{H_, H_, XN_, DM}; pg8::gemm_phase<pg8::EpiRes, pg8::StaticOrder, true, true>(F.lds, g, S, E, F.wave); }
            __syncthreads();
            { pg8::Gemm g{WL_(L, WO_PB), WL_(L, WO_P), M, DM, PLE}; pg8::StaticOrder S; S.init(M, DM, F.G, (int)blockIdx.x);
              pg8::EpiBf16<0> E{PP_, DM}; pg8::gemm_phase<pg8::EpiBf16<0>, pg8::StaticOrder, true, true>(F.lds, g, S, E, F.wave); }
        }
        SEAM(pb + 6);
        if (IN(pb + 7)) { pg8::Gemm g{XN_, WL_(L, WO_G), M, DM, DM}; pg8::StaticOrder S; S.init(M, DM, F.G, (int)blockIdx.x);
            pg8::EpiGate E{H_, PP_, DM}; pg8::gemm_phase<pg8::EpiGate, pg8::StaticOrder, true, true>(F.lds, g, S, E, F.wave); }
        SEAM(pb + 7);
    }
    if (IN(17)) norm_phase(F, H_, INP(19), nullptr, (float*)INP(20));
#undef IN
#undef SEAM
}

extern "C" void kernel_launch(void* const* d_in, const int* in_sizes, int n_in, void* d_out, int out_size, void* d_ws, size_t ws_size, hipStream_t stream) {
    static int grid = 0;
    if (grid == 0) {
        if (n_in != 20 || in_sizes[0] != M * DM || out_size != M * DM || ws_size < WS_END) { fprintf(stderr, "kernel_launch: unexpected shapes (n_in %d, in0 %d, out %d, ws %zu); nothing launched\n", n_in, n_in > 0 ? in_sizes[0] : -1, out_size, ws_size); grid = -1; return; }
        int dev = 0, cus = 0, per_cu = 0;
        if (hipGetDevice(&dev) != hipSuccess || hipDeviceGetAttribute(&cus, hipDeviceAttributeMultiprocessorCount, dev) != hipSuccess) { grid = -1; return; }
        if (hipFuncSetAttribute((const void*)mk_fwd, hipFuncAttributeMaxDynamicSharedMemorySize, LDS_BYTES) != hipSuccess) { fprintf(stderr, "kernel_launch: hipFuncSetAttribute failed\n"); grid = -1; return; }
        if (hipOccupancyMaxActiveBlocksPerMultiprocessor(&per_cu, (const void*)mk_fwd, NWAVES * 64, LDS_BYTES) != hipSuccess || per_cu < 1)
            fprintf(stderr, "kernel_launch: note: occupancy query reports %d workgroups per CU\n", per_cu);
        (void)hipGetLastError();
        grid = cus;
    }
    if (grid < 0) return;
    if (hipMemsetAsync((char*)d_ws + WS_CTL, 0, CTL_ZERO_BYTES, stream) != hipSuccess) return;
    Args a{};
    for (int i = 0; i < 20; ++i) a.in[i] = (const float*)d_in[i];
    a.out = (float*)d_out; a.ws = (unsigned char*)d_ws;
#if MK_N_LAUNCHES == 1
    a.ph_lo = 0; a.ph_hi = N_PHASES;
    hipLaunchKernelGGL(mk_fwd, dim3(grid), dim3(NWAVES * 64), LDS_BYTES, stream, a);
#else
    for (int k = 0; k < N_PHASES; ++k) { a.ph_lo = k; a.ph_hi = k + 1; hipLaunchKernelGGL(mk_fwd, dim3(grid), dim3(NWAVES * 64), LDS_BYTES, stream, a); }
#endif
    const hipError_t le = hipPeekAtLastError();
    if (le != hipSuccess) fprintf(stderr, "kernel_launch: launch failed: %s\n", hipGetErrorName(le));
}
```

```cpp
#include <hip/hip_runtime.h>
#include <cstdio>
#include <cstdint>
namespace pg8 {
#define PG8_LAS __attribute__((address_space(3)))
typedef unsigned short bf16_t;
typedef short bf16x8 __attribute__((ext_vector_type(8)));
typedef float f32x4 __attribute__((ext_vector_type(4)));
typedef unsigned u32x4 __attribute__((ext_vector_type(4)));
constexpr int BM = 256, BK = 64, HALF = 128, HTB = HALF * BK * 2  , STAGE_BYTES = 8 * HTB, NXCD = 8, WGM = 8;

__host__ __device__ __forceinline__ int lds_byte(int r, int c) { const int st = (r >> 4) * 2 + (c >> 5), rr = r & 15, cc = c & 31, ob = rr * 64 + cc * 2; return st * 1024 + (ob ^ (((ob >> 9) & 1) << 5)); }
__host__ __device__ __forceinline__ void stage_rc(int b, int& R, int& C) { const int st = b / 1024, sb = b % 1024, swz = sb ^ (((sb >> 9) & 1) << 5); R = (st >> 1) * 16 + swz / 64; C = (st & 1) * 32 + (swz % 64) / 2; }
__host__ __device__ __forceinline__ int perm32(int rho) { const int n = rho >> 4, i = rho & 15; return 8 * (i >> 2) + 4 * n + (i & 3); }

struct Unit { int pm, pn; };
struct Gemm { const bf16_t* A; const bf16_t* Bt; int M, N, K; };

struct StaticOrder {
    int nM, nN, nwg, G, c;
    __host__ __device__ void init(int M, int N, int G_, int c_) { nM = M / BM; nN = N / BM; nwg = nM * nN; G = G_; c = c_; }
    __host__ __device__ bool next(int i, Unit& u) const {
        const long L = (long)i * G + c; if (L >= nwg) return false;
        int wgid = (int)L; { const int q = nwg / NXCD, r = nwg % NXCD, xcd = wgid % NXCD, off = wgid / NXCD; wgid = (xcd < r ? xcd * (q + 1) : r * (q + 1) + (xcd - r) * q) + off; }
        const int nig = WGM * nN, gid = wgid / nig, fm = gid * WGM, gsz = (nM - fm) < WGM ? (nM - fm) : WGM;
        u.pm = fm + ((wgid % nig) % gsz); u.pn = (wgid % nig) / gsz; return true;
    }
    __device__ __forceinline__ void a_ready(const Unit&) const {}
    __device__ __forceinline__ void done(const Unit&) const {}
};
__device__ __forceinline__ unsigned cvt_pk_bf16(float lo, float hi) { unsigned r; asm volatile("v_cvt_pk_bf16_f32 %0, %1, %2" : "=v"(r) : "v"(lo), "v"(hi)); return r; }
typedef float f32x2 __attribute__((ext_vector_type(2)));
#define EGAS __attribute__((address_space(1)))
template <int ACT  > struct EpiBf16 {
    static constexpr bool PERM = true, AFTER_DRAIN = false;
    bf16_t* O; int ldc; const float* slots; PG8_LAS unsigned char* tab;
    __device__ __forceinline__ void operator()(const f32x4 (&acc)[2][2][4][2], const Unit& u, int wr, int wc, int fr, int fq) const {
        const int row0 = u.pm * BM + wr * 64 + fr, col0 = u.pn * BM + wc * 32 + 8 * fq;
        int sl = -1;
        if (slots) {
#pragma unroll
            for (int s = 0; s < 8; ++s) if (((const PG8_LAS int*)tab)[s] == u.pm) sl = s; }
#pragma unroll
        for (int ai = 0; ai < 2; ++ai)
#pragma unroll
            for (int m = 0; m < 4; ++m) { EGAS bf16_t* rowp = (EGAS bf16_t*)O + (size_t)(row0 + ai * HALF + m * 16) * ldc + col0;
                float rs = 1.f;
                if (slots) { const int rl = wr * 64 + fr + ai * HALF + m * 16;
                    if (sl >= 0) rs = ((const PG8_LAS float*)(tab + 32))[sl * 256 + rl];
                    else { const EGAS f32x4* sp = (const EGAS f32x4*)(slots + (size_t)(u.pm * BM + rl) * 64); float a = 0.f;
#pragma unroll 1
                        for (int j = 0; j < 16; ++j) { const f32x4 v = sp[j]; a += (v[0] + v[1]) + (v[2] + v[3]); }
                        rs = 1.f / sqrtf(a * (1.f / 4096.f) + 1e-6f); } }
#pragma unroll
                for (int bj = 0; bj < 2; ++bj) { f32x4 v0 = acc[ai][bj][m][0] * rs, v1 = acc[ai][bj][m][1] * rs;
                    if (ACT == 2) {
#pragma unroll
                        for (int e = 0; e < 4; ++e) { float a = v0[e] > 0.f ? v0[e] : 0.f; v0[e] = a * a; float b = v1[e] > 0.f ? v1[e] : 0.f; v1[e] = b * b; } }
                    u32x4 w; w.x = cvt_pk_bf16(v0[0], v0[1]); w.y = cvt_pk_bf16(v0[2], v0[3]); w.z = cvt_pk_bf16(v1[0], v1[1]); w.w = cvt_pk_bf16(v1[2], v1[3]);
                    *(EGAS u32x4*)(rowp + bj * HALF) = w; } }
    }
};
struct EpiRes {
    static constexpr bool PERM = true, AFTER_DRAIN = false;
    const float* res; float* out; bf16_t* hb; int ld; const float* gain; float* slots;
    __device__ __forceinline__ void operator()(const f32x4 (&acc)[2][2][4][2], const Unit& u, int wr, int wc, int fr, int fq) const {
        const int row0 = u.pm * BM + wr * 64 + fr, col0 = u.pn * BM + wc * 32 + 8 * fq;
        f32x4 gv[2][2];
#pragma unroll
        for (int bj = 0; bj < 2; ++bj)
#pragma unroll
            for (int n = 0; n < 2; ++n) gv[bj][n] = gain ? *(const EGAS f32x4*)(gain + col0 + bj * HALF + 4 * n) : (f32x4){1.f, 1.f, 1.f, 1.f};
#pragma unroll
        for (int ai = 0; ai < 2; ++ai)
#pragma unroll
            for (int m = 0; m < 4; ++m) { const int row = row0 + ai * HALF + m * 16; const size_t off = (size_t)row * ld + col0; float ss = 0.f;
#pragma unroll
                for (int bj = 0; bj < 2; ++bj) {
                    const f32x4 r0 = *(const EGAS f32x4*)(res + off + bj * HALF), r1 = *(const EGAS f32x4*)(res + off + bj * HALF + 4);
                    const f32x4 v0 = acc[ai][bj][m][0] + r0, v1 = acc[ai][bj][m][1] + r1;
                    *(EGAS f32x4*)(out + off + bj * HALF) = v0; *(EGAS f32x4*)(out + off + bj * HALF + 4) = v1;
                    ss += (v0[0] * v0[0] + v0[1] * v0[1]) + (v0[2] * v0[2] + v0[3] * v0[3]) + (v1[0] * v1[0] + v1[1] * v1[1]) + (v1[2] * v1[2] + v1[3] * v1[3]);
                    if (hb) { const f32x4 s0 = v0 * gv[bj][0], s1 = v1 * gv[bj][1];
                        u32x4 w; w.x = cvt_pk_bf16(s0[0], s0[1]); w.y = cvt_pk_bf16(s0[2], s0[3]); w.z = cvt_pk_bf16(s1[0], s1[1]); w.w = cvt_pk_bf16(s1[2], s1[3]);
                        *(EGAS u32x4*)(hb + off + bj * HALF) = w; } }
                if (slots) { ss += __shfl_xor(ss, 16); ss += __shfl_xor(ss, 32); if (fq == 0) ((EGAS float*)slots)[(size_t)row * 64 + u.pn * 4 + wc] = ss; } }
    }
};
struct EpiGate {
    static constexpr bool PERM = true, AFTER_DRAIN = false;
    float* h; const bf16_t* pp; int ld; bf16_t* hb; const float* gain; float* slots;
    __device__ __forceinline__ void operator()(const f32x4 (&acc)[2][2][4][2], const Unit& u, int wr, int wc, int fr, int fq) const {
        const int row0 = u.pm * BM + wr * 64 + fr, col0 = u.pn * BM + wc * 32 + 8 * fq;
        f32x4 gv[2][2];
#pragma unroll
        for (int bj = 0; bj < 2; ++bj)
#pragma unroll
            for (int n = 0; n < 2; ++n) gv[bj][n] = hb ? *(const EGAS f32x4*)(gain + col0 + bj * HALF + 4 * n) : (f32x4){1.f, 1.f, 1.f, 1.f};
#pragma unroll
        for (int ai = 0; ai < 2; ++ai)
#pragma unroll
            for (int m = 0; m < 4; ++m) { const int row = row0 + ai * HALF + m * 16; const size_t off = (size_t)row * ld + col0; float ss = 0.f;
#pragma unroll
                for (int bj = 0; bj < 2; ++bj) {
                    f32x4 r0 = *(const EGAS f32x4*)(h + off + bj * HALF), r1 = *(const EGAS f32x4*)(h + off + bj * HALF + 4);
                    const u32x4 pw = *(const EGAS u32x4*)(pp + off + bj * HALF);
                    const f32x4 a0 = acc[ai][bj][m][0], a1 = acc[ai][bj][m][1];
                    const unsigned pwv[4] = {pw.x, pw.y, pw.z, pw.w};
#pragma unroll
                    for (int e = 0; e < 4; ++e) {
                        const float p0 = __builtin_bit_cast(float, (e & 1) ? (pwv[e >> 1] & 0xffff0000u) : (pwv[e >> 1] << 16));
                        const float p1 = __builtin_bit_cast(float, (e & 1) ? (pwv[2 + (e >> 1)] & 0xffff0000u) : (pwv[2 + (e >> 1)] << 16));
                        r0[e] += p0 / (1.f + __expf(-a0[e])); r1[e] += p1 / (1.f + __expf(-a1[e])); }
                    *(EGAS f32x4*)(h + off + bj * HALF) = r0; *(EGAS f32x4*)(h + off + bj * HALF + 4) = r1;
                    if (hb) { ss += (r0[0] * r0[0] + r0[1] * r0[1]) + (r0[2] * r0[2] + r0[3] * r0[3]) + (r1[0] * r1[0] + r1[1] * r1[1]) + (r1[2] * r1[2] + r1[3] * r1[3]);
                        const f32x4 s0 = r0 * gv[bj][0], s1 = r1 * gv[bj][1];
                        u32x4 w; w.x = cvt_pk_bf16(s0[0], s0[1]); w.y = cvt_pk_bf16(s0[2], s0[3]); w.z = cvt_pk_bf16(s1[0], s1[1]); w.w = cvt_pk_bf16(s1[2], s1[3]);
                        *(EGAS u32x4*)(hb + off + bj * HALF) = w; } }
                if (hb) { ss += __shfl_xor(ss, 16); ss += __shfl_xor(ss, 32); if (fq == 0) ((EGAS float*)slots)[(size_t)row * 64 + u.pn * 4 + wc] = ss; } }
    }
};
template <class Sched> __device__ __forceinline__ void build_rstd_tab(PG8_LAS unsigned char* tab, const Sched& S, const float* slots, int tid) {
    PG8_LAS int* pmid = (PG8_LAS int*)tab; PG8_LAS float* rs = (PG8_LAS float*)(tab + 32);
    if (tid == 0) { int n = 0;
        for (int s = 0; s < 8; ++s) pmid[s] = -1;
        Unit u; for (int i = 0; S.next(i, u); ++i) { bool f = false; for (int s = 0; s < 8; ++s) f |= (pmid[s] == u.pm); if (!f && n < 8) { pmid[n] = u.pm; ++n; } } }
    __syncthreads();
    for (int e = tid; e < 8 * 256; e += 512) { const int s = e >> 8, r = e & 255; const int pm = pmid[s];
        if (pm >= 0) { const EGAS f32x4* sp = (const EGAS f32x4*)(slots + (size_t)(pm * BM + r) * 64); float a = 0.f;
#pragma unroll
            for (int j = 0; j < 16; ++j) { const f32x4 v = sp[j]; a += (v[0] + v[1]) + (v[2] + v[3]); }
            rs[e] = 1.f / sqrtf(a * (1.f / 4096.f) + 1e-6f); } }
    __syncthreads();
}
struct TailOrder {
    int nN, nwg, G2, c2;
    __device__ void init(int M, int N, int G, int c, int c0) { nN = N / BM; nwg = (M / BM) * nN; G2 = G - c0; c2 = c - c0; }
    __device__ bool next(int i, Unit& u) const { if (c2 < 0) return false; const int L = i * G2 + c2; if (L >= nwg) return false; u.pm = L / nN; u.pn = L - u.pm * nN; return true; }
    __device__ __forceinline__ void a_ready(const Unit&) const {}
    __device__ __forceinline__ void done(const Unit&) const {}
};
template <class Epi, class Sched, bool ALIGN_EPI = false, bool SP2 = false>
__device__ __forceinline__ void gemm_phase(PG8_LAS unsigned char* lds, const Gemm g, const Sched& S, const Epi& E, const int wave_in) {
    int lane; asm volatile("v_mbcnt_lo_u32_b32 %0, -1, 0\n\tv_mbcnt_hi_u32_b32 %0, -1, %0" : "=v"(lane));
    const int wid = wave_in, tid = wid * 64 + lane, wr = wid >> 2, wc = wid & 3, fr = lane & 15, fq = lane >> 4;
    const int K = g.K, nt = K / BK;
    unsigned voffA[2], voffB[2];
#pragma unroll
    for (int i = 0; i < 2; ++i) { int R, C; stage_rc(tid * 16 + i * 8192, R, C); const int Rb = Epi::PERM ? ((R & ~31) + perm32(R & 31)) : R;
        voffA[i] = (unsigned)(R * K + C) * 2u; voffB[i] = (unsigned)(Rb * K + C) * 2u; }
    const size_t kstep = (size_t)(BK * 2);
    const size_t hstep = (size_t)HALF * K * 2;
    const size_t tstep = 2 * hstep;
    const unsigned ldsw = (unsigned)wid * 1024u;
    const int aoff = lds_byte(wr * 64 + fr, fq * 8), boff = lds_byte(wc * 32 + fr, fq * 8);
#define PG8_SA(b, h) (((b) * 2 + (h)) * HTB)
#define PG8_SB(b, h) ((4 + (b) * 2 + (h)) * HTB)
#define PG8_STAGE(bufoff, gbase, voff) do { _Pragma("unroll") for (int _i = 0; _i < 2; ++_i) \
        __builtin_amdgcn_global_load_lds((const unsigned*)((const char*)(gbase) + (voff)[_i]), (PG8_LAS unsigned*)(lds + (bufoff) + ldsw + _i * 8192), 16, 0, 0); } while (0)
#define PG8_LDA(dst, b, h) do { _Pragma("unroll") for (int m = 0; m < 4; ++m) _Pragma("unroll") for (int k = 0; k < 2; ++k) dst[m][k] = *(const PG8_LAS bf16x8*)(lds + PG8_SA(b, h) + aoff + m * 2048 + k * 1024); } while (0)
#define PG8_LDB(dst, b, h) do { _Pragma("unroll") for (int n = 0; n < 2; ++n) _Pragma("unroll") for (int k = 0; k < 2; ++k) dst[n][k] = *(const PG8_LAS bf16x8*)(lds + PG8_SB(b, h) + boff + n * 2048 + k * 1024); } while (0)
#define PG8_MMA(ai, bj, At, Bt) do { __builtin_amdgcn_s_setprio(1); _Pragma("unroll") for (int m = 0; m < 4; ++m) _Pragma("unroll") for (int n = 0; n < 2; ++n) _Pragma("unroll") for (int k = 0; k < 2; ++k) \
        acc[ai][bj][m][n] = __builtin_amdgcn_mfma_f32_16x16x32_bf16(Bt[n][k], At[m][k], acc[ai][bj][m][n], 0, 0, 0); __builtin_amdgcn_s_setprio(0); } while (0)
#define PG8_WAIT_V(n) asm volatile("s_waitcnt vmcnt(" #n ")" ::: "memory")
#define PG8_WAIT_L(n) asm volatile("s_waitcnt lgkmcnt(" #n ")" ::: "memory")
#define PG8_BAR __builtin_amdgcn_s_barrier()
#define PG8_SCHED __builtin_amdgcn_sched_barrier(0)
    Unit cur, nxt; int ui = 0;
    if (!S.next(0, cur)) return;
    f32x4 acc[2][2][4][2];
#pragma unroll
    for (int a = 0; a < 2; ++a)
#pragma unroll
        for (int b = 0; b < 2; ++b)
#pragma unroll
            for (int m = 0; m < 4; ++m)
#pragma unroll
                for (int n = 0; n < 2; ++n) acc[a][b][m][n] = (f32x4){0.f, 0.f, 0.f, 0.f};
    bf16x8 At[4][2], B0[2][2], B1[2][2];
    const char* cA = (const char*)g.A + (size_t)cur.pm * tstep; const char* cB = (const char*)g.Bt + (size_t)cur.pn * tstep;
    S.a_ready(cur);
    if constexpr (SP2) {
        PG8_STAGE(PG8_SB(0, 0), cB, voffB); PG8_STAGE(PG8_SB(0, 1), cB + hstep, voffB); PG8_STAGE(PG8_SA(0, 0), cA, voffA); PG8_STAGE(PG8_SA(0, 1), cA + hstep, voffA);
        if (wr == 1) PG8_BAR;
        PG8_WAIT_V(2); PG8_BAR;
        PG8_STAGE(PG8_SB(1, 0), cB + kstep, voffB); PG8_STAGE(PG8_SA(1, 0), cA + kstep, voffA); PG8_STAGE(PG8_SB(1, 1), cB + hstep + kstep, voffB);
        PG8_WAIT_V(6); PG8_BAR;
    } else {
        PG8_STAGE(PG8_SB(0, 0), cB, voffB); PG8_STAGE(PG8_SA(0, 0), cA, voffA); PG8_STAGE(PG8_SB(0, 1), cB + hstep, voffB); PG8_STAGE(PG8_SA(0, 1), cA + hstep, voffA);
        if (wr == 1) PG8_BAR;
        PG8_WAIT_V(4); PG8_BAR;
        PG8_STAGE(PG8_SB(1, 0), cB + kstep, voffB); PG8_STAGE(PG8_SA(1, 0), cA + kstep, voffA); PG8_STAGE(PG8_SB(1, 1), cB + hstep + kstep, voffB);
        PG8_WAIT_V(6); PG8_BAR;
    }
    for (;;) {
        const bool has_next = S.next(ui + 1, nxt);
        const char* nA = has_next ? (const char*)g.A + (size_t)nxt.pm * tstep : cA; const char* nB = has_next ? (const char*)g.Bt + (size_t)nxt.pn * tstep : cB;
        for (int t = 0; t < nt; t += 2) {
            const bool last = (t == nt - 2);
            const char* a1 = cA + (size_t)(t + 1) * kstep;
            const char* a2 = last ? nA : cA + (size_t)(t + 2) * kstep; const char* b2 = last ? nB : cB + (size_t)(t + 2) * kstep;
            const char* a3 = a2 + kstep; const char* b3 = b2 + kstep;
            if (last && has_next) S.a_ready(nxt);
            if constexpr (SP2) {
            PG8_LDB(B0, 0, 0); PG8_LDB(B1, 0, 1); PG8_SCHED; PG8_LDA(At, 0, 0); PG8_STAGE(PG8_SA(1, 1), a1 + hstep, voffA);
            PG8_WAIT_V(8); PG8_WAIT_L(0); PG8_BAR; PG8_MMA(0, 0, At, B0); PG8_MMA(0, 1, At, B1); PG8_BAR; PG8_SCHED;
            PG8_LDA(At, 0, 1); PG8_STAGE(PG8_SB(0, 0), b2, voffB); PG8_STAGE(PG8_SB(0, 1), b2 + hstep, voffB); PG8_STAGE(PG8_SA(0, 0), a2, voffA);
            PG8_WAIT_V(8); PG8_WAIT_L(0); PG8_BAR; PG8_MMA(1, 0, At, B0); PG8_MMA(1, 1, At, B1); PG8_BAR; PG8_SCHED;
            PG8_LDB(B0, 1, 0); PG8_LDB(B1, 1, 1); PG8_SCHED; PG8_LDA(At, 1, 0); PG8_STAGE(PG8_SA(0, 1), a2 + hstep, voffA);
            PG8_WAIT_V(8); PG8_WAIT_L(0); PG8_BAR; PG8_MMA(0, 0, At, B0); PG8_MMA(0, 1, At, B1); PG8_BAR; PG8_SCHED;
            PG8_LDA(At, 1, 1); PG8_STAGE(PG8_SB(1, 0), b3, voffB); PG8_STAGE(PG8_SB(1, 1), b3 + hstep, voffB); PG8_STAGE(PG8_SA(1, 0), a3, voffA);
            PG8_WAIT_V(8); PG8_WAIT_L(0); PG8_BAR; PG8_MMA(1, 0, At, B0); PG8_MMA(1, 1, At, B1); PG8_BAR; PG8_SCHED;
            } else {
            PG8_LDB(B0, 0, 0); PG8_SCHED; PG8_LDA(At, 0, 0); PG8_STAGE(PG8_SA(1, 1), a1 + hstep, voffA);
            PG8_WAIT_L(8); PG8_BAR; PG8_WAIT_L(0); PG8_MMA(0, 0, At, B0); PG8_BAR; PG8_SCHED;
            PG8_LDB(B1, 0, 1); PG8_STAGE(PG8_SB(0, 0), b2, voffB);
            PG8_BAR; PG8_WAIT_L(0); PG8_MMA(0, 1, At, B1); PG8_BAR;
            PG8_LDA(At, 0, 1); PG8_STAGE(PG8_SA(0, 0), a2, voffA);
            PG8_BAR; PG8_WAIT_L(0); PG8_MMA(1, 0, At, B0); PG8_BAR; PG8_SCHED;
            PG8_STAGE(PG8_SB(0, 1), b2 + hstep, voffB);
            PG8_WAIT_V(6); PG8_BAR; PG8_MMA(1, 1, At, B1); PG8_BAR;
            PG8_LDB(B0, 1, 0); PG8_SCHED; PG8_LDA(At, 1, 0); PG8_STAGE(PG8_SA(0, 1), a2 + hstep, voffA);
            PG8_WAIT_L(8); PG8_BAR; PG8_WAIT_L(0); PG8_MMA(0, 0, At, B0); PG8_BAR; PG8_SCHED;
            PG8_LDB(B1, 1, 1); PG8_STAGE(PG8_SB(1, 0), b3, voffB);
            PG8_BAR; PG8_WAIT_L(0); PG8_MMA(0, 1, At, B1); PG8_BAR;
            PG8_LDA(At, 1, 1); PG8_STAGE(PG8_SA(1, 0), a3, voffA);
            PG8_BAR; PG8_WAIT_L(0); PG8_MMA(1, 0, At, B0); PG8_BAR; PG8_SCHED;
            PG8_STAGE(PG8_SB(1, 1), b3 + hstep, voffB);
            PG8_WAIT_V(6); PG8_BAR; PG8_MMA(1, 1, At, B1); PG8_BAR;
            }
        }
        if constexpr (ALIGN_EPI) { if (wr == 0) PG8_BAR; }
        if constexpr (!Epi::AFTER_DRAIN) { E(acc, cur, wr, wc, fr, fq); S.done(cur); }
        if (!has_next) break;
#pragma unroll
        for (int a = 0; a < 2; ++a)
#pragma unroll
            for (int b = 0; b < 2; ++b)
#pragma unroll
                for (int m = 0; m < 4; ++m)
#pragma unroll
                    for (int n = 0; n < 2; ++n) acc[a][b][m][n] = (f32x4){0.f, 0.f, 0.f, 0.f};
        cur = nxt; cA = nA; cB = nB; ++ui;
        if constexpr (ALIGN_EPI) { if (wr == 1) PG8_BAR; }
    }
    PG8_WAIT_V(0);
    if constexpr (!ALIGN_EPI) { if (wr == 0) PG8_BAR; }
    PG8_BAR;
    if constexpr (Epi::AFTER_DRAIN) { E.fused(acc, cur, wr, wc, fr, fq, lds, wid, lane); S.done(cur); }
#undef PG8_SA
#undef PG8_SB
#undef PG8_STAGE
#undef PG8_LDA
#undef PG8_LDB
#undef PG8_MMA
#undef PG8_WAIT_V
#undef PG8_WAIT_L
#undef PG8_BAR
#undef PG8_SCHED
}
}
#define GAS __attribute__((address_space(1)))
#define LAS __attribute__((address_space(3)))
typedef unsigned short bf16;
typedef unsigned v4u __attribute__((ext_vector_type(4)));
typedef float f32x4 __attribute__((ext_vector_type(4)));
typedef short bf16x8 __attribute__((ext_vector_type(8)));
typedef GAS unsigned gu32;
typedef GAS unsigned long long gu64;
#define RLX_AGENT __ATOMIC_RELAXED, __HIP_MEMORY_SCOPE_AGENT
#define LDS_WAIT() asm volatile("s_waitcnt lgkmcnt(0)" ::: "memory")
#define VM_WAIT() asm volatile("s_waitcnt vmcnt(0)" ::: "memory")
__device__ __forceinline__ unsigned long long rt() { return __builtin_amdgcn_s_memrealtime(); }
__device__ __forceinline__ unsigned f2bf(float f) { unsigned u = __builtin_bit_cast(unsigned, f); return (u + 0x7fffu + ((u >> 16) & 1u)) >> 16; }
__device__ __forceinline__ unsigned pk2(float lo, float hi) { return f2bf(lo) | (f2bf(hi) << 16); }
#define XB_TMO      128
#define XB_XCNT(j)  (256  + 64 * (j))
#define XB_XSUB(j)  (1280 + 64 * (j))
#define XB_XGEN(j)  (2304 + 64 * (j))
#define XB_TOP      3328
#define XB_TOPGEN   3392
#define XCD_BAR_WORDS 3456
#define XB_SPIN_CAP (1u << 18)

__device__ __forceinline__ unsigned xb_ld(unsigned* p)              { return __hip_atomic_load(p, __ATOMIC_RELAXED, __HIP_MEMORY_SCOPE_AGENT); }
__device__ __forceinline__ unsigned xb_add(unsigned* p, unsigned v) { return __hip_atomic_fetch_add(p, v, __ATOMIC_RELAXED, __HIP_MEMORY_SCOPE_AGENT); }
__device__ __forceinline__ unsigned xb_xcc_id() { return (unsigned)__builtin_amdgcn_s_getreg((3 << 11) | 20) & 0xFu; }
#define XB_SPIN(cond, bar) do { unsigned _sp = 0; while (cond) { __builtin_amdgcn_s_sleep(1); \
    if ((++_sp & 255u) == 0u) { if (xb_ld(&(bar)[XB_TMO])) break; if (_sp > XB_SPIN_CAP) { atomicAdd(&(bar)[XB_TMO], 1u); break; } } } } while (0)

struct XcdBarrier {
    unsigned* bar; unsigned x;
    volatile LAS unsigned* st;
};

__device__ __forceinline__ XcdBarrier xcd_barrier_post(unsigned* bar, volatile LAS unsigned* st) {
    XcdBarrier b; b.bar = bar; b.x = xb_xcc_id(); b.st = st;
    if (threadIdx.x == 0) (void)xb_add(&bar[XB_XCNT(b.x)], 1u);
    return b;
}
__device__ __forceinline__ void xcd_barrier_complete(unsigned* bar, unsigned x, unsigned& nloc, unsigned& nx) {
    const unsigned G = gridDim.x * gridDim.y * gridDim.z;
    unsigned sum, cnt, mine, sp = 0u;
    for (;;) {
        sum = 0u; cnt = 0u; mine = 0u;
#pragma unroll
        for (unsigned j = 0; j < 16; ++j) { const unsigned c = xb_ld(&bar[XB_XCNT(j)]); sum += c; cnt += (c > 0u) ? 1u : 0u; mine = (j == x) ? c : mine; }
        if (sum == G) break;
        __builtin_amdgcn_s_sleep(1);
        if ((++sp & 255u) == 0u) { if (xb_ld(&bar[XB_TMO])) break; if (sp > XB_SPIN_CAP) { atomicAdd(&bar[XB_TMO], 1u); break; } }
    }
    nloc = mine > 0u ? mine : 1u; nx = cnt > 0u ? cnt : 1u;
}

__device__ __forceinline__ void xcd_barrier(const XcdBarrier& b, const bool is_t0) {
    asm volatile("s_waitcnt vmcnt(0)" ::: "memory");
    __syncthreads();
    if (is_t0) {
        unsigned* bar = b.bar;
        __builtin_amdgcn_s_waitcnt(0);
        unsigned nloc = b.st[0], nx = b.st[1];
        if (nloc == 0u) { xcd_barrier_complete(bar, b.x, nloc, nx); b.st[0] = nloc; b.st[1] = nx; }
        const unsigned old = xb_add(&bar[XB_XSUB(b.x)], 1u);
        const unsigned gen = old / nloc;
        if (old + 1u == (gen + 1u) * nloc) {
            __builtin_amdgcn_fence(__ATOMIC_RELEASE, "agent");
            asm volatile("s_waitcnt vmcnt(0)" ::: "memory");
            const unsigned og = xb_add(&bar[XB_TOP], 1u);
            const unsigned tg = og / nx;
            if (og + 1u == (tg + 1u) * nx) xb_add(&bar[XB_TOPGEN], 1u);
            else XB_SPIN(xb_ld(&bar[XB_TOPGEN]) == tg, bar);
            __builtin_amdgcn_fence(__ATOMIC_ACQUIRE, "agent");
            xb_add(&bar[XB_XGEN(b.x)], 1u);
            asm volatile("s_waitcnt vmcnt(0)" ::: "memory");
        } else {
            XB_SPIN(xb_ld(&bar[XB_XGEN(b.x)]) == gen, bar);
            __builtin_amdgcn_fence(__ATOMIC_ACQUIRE, "agent");
            asm volatile("s_waitcnt vmcnt(0)" ::: "memory");
        }
    }
    __syncthreads();
}
typedef unsigned v2u __attribute__((ext_vector_type(2)));
#ifndef MK_N_LAUNCHES
#define MK_N_LAUNCHES 1
#endif
constexpr int NWAVES = 8;
constexpr int BATCH = 2, SEQ = 8192, DM = 4096, M = BATCH * SEQ, INC = 7424, FF = 16384, PLE = 256, DEPTH = 2;
constexpr int C_AV = 0, C_AG = 1024, C_BG = 2048, C_CG = 3072, C_BX = 4096, C_Q = 5120, C_K = 6144, C_V = 6272, C_D = 6400;
constexpr float EPS = 1e-6f;
constexpr int N_PHASES = 18;
constexpr size_t MiB = 1u << 20;
constexpr size_t WS_CTL = 0, CTL_ZERO_BYTES = 1 * MiB;
constexpr size_t WS_W = 2 * MiB, W_LAYER = 388 * MiB;
constexpr size_t WO_IN = 0, WO_OUT = 58 * MiB, WO_UP = 90 * MiB, WO_DOWN = 218 * MiB, WO_G = 346 * MiB, WO_P = 378 * MiB, WO_PB = 380 * MiB;
constexpr size_t WS_H = 780 * MiB, WS_XN = 1036 * MiB, WS_PP = 1164 * MiB, WS_BIG = 1292 * MiB, WS_Y = WS_BIG + 232 * MiB, WS_SLOT = 1804 * MiB, WS_XN2 = 1808 * MiB, WS_END = 1936 * MiB;
constexpr size_t WS_RSTD = 1 * MiB + 512 * 1024;
constexpr int CW_BAR = 4096;
constexpr size_t WS_CWT = 1 * MiB;
constexpr int RING_BYTES = 131072, LDSCTL_OFF = RING_BYTES, MISC_OFF = LDSCTL_OFF + 320, LDS_BYTES = 147456;

struct Frame {
    LAS unsigned char* lds;
    volatile LAS unsigned* MISC;
    gu32* ctl;
    int wave, vcu, G;
};
__device__ __forceinline__ int fresh_lane() { int l; asm volatile("v_mbcnt_lo_u32_b32 %0, -1, 0\n\tv_mbcnt_hi_u32_b32 %0, -1, %0" : "=v"(l)); return l; }

__device__ __forceinline__ float wave_sum(float v) {
#pragma unroll
    for (int o = 1; o < 64; o <<= 1) v += __shfl_xor(v, o);
    return v;
}
__device__ __forceinline__ float bf2f(bf16 u) { return __builtin_bit_cast(float, (unsigned)u << 16); }
__device__ __forceinline__ float bflo(unsigned w) { return __builtin_bit_cast(float, w << 16); }
__device__ __forceinline__ float bfhi(unsigned w) { return __builtin_bit_cast(float, w & 0xffff0000u); }

__device__ __forceinline__ void tr_item(const float* W, int K, int ldw, int nblk, bf16* WT, LAS float* scr, int item, int lane) {
    const int kb = item / nblk, nb = item - kb * nblk, k0 = 64 * kb, n0 = 32 * nb;
#pragma unroll
    for (int i = 0; i < 32; ++i) { const int kk = 2 * i + (lane >> 5); scr[kk * 33 + (lane & 31)] = ((const GAS float*)W)[(size_t)(k0 + kk) * ldw + n0 + (lane & 31)]; }
    LDS_WAIT(); asm volatile("" ::: "memory");
    const int c = lane & 7;
#pragma unroll
    for (int j = 0; j < 4; ++j) { const int n = (lane >> 3) + 8 * j; const LAS float* s = scr + (8 * c) * 33 + n;
        v4u o; o.x = pk2(s[0 * 33], s[1 * 33]); o.y = pk2(s[2 * 33], s[3 * 33]); o.z = pk2(s[4 * 33], s[5 * 33]); o.w = pk2(s[6 * 33], s[7 * 33]);
        *(GAS v4u*)(WT + (size_t)(n0 + n) * K + k0 + 8 * c) = o; }
    LDS_WAIT(); asm volatile("" ::: "memory");
}
struct ProIn { const float *p, *w_in, *pool_w, *w_out, *w_up, *w_down, *w_g, *w_p, *conv_w; unsigned char* ws; };
__device__ __forceinline__ void prologue(Frame& F, const ProIn& I) {
    const int lane_ = fresh_lane();
    LAS float* scr = (LAS float*)(F.lds + F.wave * 16384);
    const int gw = F.vcu * NWAVES + F.wave, NGW = F.G * NWAVES;
    constexpr int I_IN = 64 * 200, I_OUT = 64 * 128, I_UP = 64 * 512, I_DOWN = 256 * 128, I_G = 64 * 128, I_P = 4 * 128;
    constexpr int I_LAYER = I_IN + I_OUT + I_UP + I_DOWN + I_G + I_P;
    for (int it = gw; it < DEPTH * I_LAYER; it += NGW) {
        const int L = it / I_LAYER; int r = it - L * I_LAYER;
        unsigned char* wl = I.ws + WS_W + (size_t)L * W_LAYER;
        if (r < I_IN) { tr_item(I.w_in + (size_t)L * DM * INC, DM, INC, 200, (bf16*)(wl + WO_IN), scr, r, lane_); continue; } r -= I_IN;
        if (r < I_OUT) { tr_item(I.w_out + (size_t)L * DM * DM, DM, DM, 128, (bf16*)(wl + WO_OUT), scr, r, lane_); continue; } r -= I_OUT;
        if (r < I_UP) { tr_item(I.w_up + (size_t)L * DM * FF, DM, FF, 512, (bf16*)(wl + WO_UP), scr, r, lane_); continue; } r -= I_UP;
        if (r < I_DOWN) { tr_item(I.w_down + (size_t)L * FF * DM, FF, DM, 128, (bf16*)(wl + WO_DOWN), scr, r, lane_); continue; } r -= I_DOWN;
        if (r < I_G) { tr_item(I.w_g + (size_t)L * DM * DM, DM, DM, 128, (bf16*)(wl + WO_G), scr, r, lane_); continue; } r -= I_G;
        tr_item(I.w_p + (size_t)L * PLE * DM, PLE, DM, 128, (bf16*)(wl + WO_P), scr, r, lane_);
    }
    for (int it = gw; it < DEPTH * 2048; it += NGW) {
        const int L = it >> 11, r = it & 2047, kblk = r & 63, g = (r >> 6) & 3, dch = r >> 8;
        const int k = kblk * 64 + lane_;
        const GAS float* a = (const GAS float*)I.w_in + (size_t)L * DM * INC + (size_t)k * INC + C_D + g * 256;
        const GAS float* pw = (const GAS float*)I.pool_w + (size_t)L * 4 * 65536 + (size_t)g * 65536 + dch * 32;
        float acc[32];
#pragma unroll
        for (int d = 0; d < 32; ++d) acc[d] = 0.f;
#pragma unroll 1
        for (int c4 = 0; c4 < 64; ++c4) { const f32x4 av = ((const GAS f32x4*)a)[c4];
#pragma unroll
            for (int e = 0; e < 4; ++e)
#pragma unroll
                for (int d = 0; d < 32; ++d) acc[d] += av[e] * pw[(c4 * 4 + e) * 256 + d]; }
        GAS bf16* o = (GAS bf16*)(I.ws + WS_W + (size_t)L * W_LAYER + WO_IN) + (size_t)(C_D + g * 256 + dch * 32) * DM + k;
#pragma unroll
        for (int d = 0; d < 32; ++d) o[(size_t)d * DM] = (bf16)f2bf(acc[d]);
    }
    for (int e = gw * 64 + lane_; e < DEPTH * 1024 * 32; e += NGW * 64) { const int L = e >> 15, c = (e >> 5) & 1023, k = e & 31;
        ((GAS float*)(I.ws + WS_CWT))[e] = (k < 31) ? ((const GAS float*)I.conv_w)[(size_t)L * 31 * 1024 + k * 1024 + c] : 0.f; }
    for (int ch = gw * 64 + lane_; ch < DEPTH * M * PLE / 8; ch += NGW * 64) {
        const int L = ch / (M * PLE / 8), r = ch - L * (M * PLE / 8);
        const f32x4 a = ((const GAS f32x4*)I.p)[2 * (size_t)ch], b = ((const GAS f32x4*)I.p)[2 * (size_t)ch + 1];
        v4u o; o.x = pk2(a.x, a.y); o.y = pk2(a.z, a.w); o.z = pk2(b.x, b.y); o.w = pk2(b.z, b.w);
        ((GAS v4u*)(I.ws + WS_W + (size_t)L * W_LAYER + WO_PB))[r] = o;
    }
}

__device__ __forceinline__ void norm_phase(Frame& F, const float* src, const float* g, bf16* dst_bf, float* dst_f) {
    const int lane_ = fresh_lane();
    const int gw = F.vcu * NWAVES + F.wave, NGW = F.G * NWAVES;
    for (int m = gw; m < M; m += NGW) {
        const GAS f32x4* xr = (const GAS f32x4*)(src + (size_t)m * DM) + lane_;
        f32x4 v[16]; float s = 0.f;
#pragma unroll
        for (int j = 0; j < 16; ++j) { v[j] = xr[64 * j]; s += (v[j].x * v[j].x + v[j].y * v[j].y) + (v[j].z * v[j].z + v[j].w * v[j].w); }
        const float rstd = 1.f / sqrtf(wave_sum(s) * (1.f / DM) + EPS);
        const GAS f32x4* gr = (const GAS f32x4*)g + lane_;
        if (dst_bf) { GAS unsigned long long* o8 = (GAS unsigned long long*)(dst_bf + (size_t)m * DM) + lane_;
#pragma unroll
            for (int j = 0; j < 16; ++j) { const f32x4 gv = gr[64 * j];
                o8[64 * j] = (unsigned long long)pk2(v[j].x * rstd * gv.x, v[j].y * rstd * gv.y) | ((unsigned long long)pk2(v[j].z * rstd * gv.z, v[j].w * rstd * gv.w) << 32); } }
        else { GAS f32x4* o = (GAS f32x4*)(dst_f + (size_t)m * DM) + lane_;
#pragma unroll
            for (int j = 0; j < 16; ++j) { const f32x4 gv = gr[64 * j]; o[64 * j] = (f32x4){v[j].x * rstd * gv.x, v[j].y * rstd * gv.y, v[j].z * rstd * gv.z, v[j].w * rstd * gv.w}; } }
    }
}

__device__ __forceinline__ void rowstat_phase(Frame& F, const float* slots, float* rstd) {
    const int lane_ = fresh_lane(); const int gt = (F.vcu * NWAVES + F.wave) * 64 + lane_, NT = F.G * NWAVES * 64;
    for (int r = gt; r < M; r += NT) { const GAS f32x4* sp = (const GAS f32x4*)(slots + (size_t)r * 64); float a = 0.f;
#pragma unroll
        for (int j = 0; j < 16; ++j) { const f32x4 v = sp[j]; a += (v.x + v.y) + (v.z + v.w); }
        ((GAS float*)rstd)[r] = 1.f / sqrtf(a * (1.f / DM) + EPS); }
}

struct MixP { const bf16* proj; bf16* Y; const float *conv_wt, *conv_b, *ln_g, *ln_b, *sconv_w, *sinks, *pool_scale, *gain; };

template <int N> __device__ __forceinline__ void block_reduce(float (&v)[N], LAS float* red, int wave, int lane, int tid) {
#pragma unroll
    for (int i = 0; i < N; ++i) v[i] = wave_sum(v[i]);
    if (lane == 0) {
#pragma unroll
        for (int i = 0; i < N; ++i) red[wave * N + i] = v[i]; }
    __syncthreads();
    if (tid < N) { float s = 0.f;
#pragma unroll
        for (int w = 0; w < NWAVES; ++w) s += red[w * N + tid];
        red[NWAVES * N + tid] = s; }
    __syncthreads();
#pragma unroll
    for (int i = 0; i < N; ++i) v[i] = red[NWAVES * N + i];
    __syncthreads();
}

__device__ __forceinline__ void stage_rows(const bf16* pj, int t_first, int nrows, int col0, LAS bf16* dst, int tid) {
#pragma unroll 8
    for (int it = tid; it < nrows * 128; it += NWAVES * 64) { const int r = it >> 7, ch = (it & 127) * 8; const int t = t_first + r;
        v4u v = (v4u){0u, 0u, 0u, 0u};
        if (t >= 0) v = *(const GAS v4u*)(pj + (size_t)t * INC + col0 + ch);
        *(LAS v4u*)(dst + r * 1024 + ch) = v; }
}
__device__ __forceinline__ float glu1(float val, float gt) { return val / (1.f + __expf(-gt)); }
__device__ __forceinline__ void mix_abd_tile(Frame& F, const MixP& P, int tile, LAS unsigned char* lds) {
    const int lane = fresh_lane(), wave = F.wave, tid = wave * 64 + lane;
    const int b = tile >> 9, t0 = (tile & 511) * 16;
    const bf16* pj = P.proj + (size_t)b * SEQ * INC;
    bf16* yo = P.Y + ((size_t)b * SEQ + t0) * DM;
    LAS bf16* L0 = (LAS bf16*)lds;
    LAS float* red = (LAS float*)(lds + 120 * 1024);
    {
#pragma unroll 4
        for (int it = tid; it < 46 * 128; it += NWAVES * 64) { const int r = it >> 7, ch = (it & 127) * 8; const int t = t0 - 30 + r;
            v4u o = (v4u){0u, 0u, 0u, 0u};
            if (t >= 0) { const bf16* row = pj + (size_t)t * INC + ch; const v4u va = *(const GAS v4u*)(row + C_AV), vg = *(const GAS v4u*)(row + C_AG);
                o.x = pk2(glu1(bflo(va.x), bflo(vg.x)), glu1(bfhi(va.x), bfhi(vg.x))); o.y = pk2(glu1(bflo(va.y), bflo(vg.y)), glu1(bfhi(va.y), bfhi(vg.y)));
                o.z = pk2(glu1(bflo(va.z), bflo(vg.z)), glu1(bfhi(va.z), bfhi(vg.z))); o.w = pk2(glu1(bflo(va.w), bflo(vg.w)), glu1(bfhi(va.w), bfhi(vg.w))); }
            *(LAS v4u*)(L0 + r * 1024 + ch) = o; }
        __syncthreads();
        float ya[2][16], st[32];
#pragma unroll
        for (int i = 0; i < 32; ++i) st[i] = 0.f;
#pragma unroll
        for (int cc = 0; cc < 2; ++cc) { const int c = tid + 512 * cc;
            float w[32];
            const GAS f32x4* wp = (const GAS f32x4*)(P.conv_wt + (size_t)c * 32);
#pragma unroll
            for (int k = 0; k < 8; ++k) { const f32x4 v = wp[k]; w[4 * k] = v.x; w[4 * k + 1] = v.y; w[4 * k + 2] = v.z; w[4 * k + 3] = v.w; }
            const float bias = ((const GAS float*)P.conv_b)[c];
            float a[16];
#pragma unroll
            for (int i = 0; i < 16; ++i) a[i] = bias;
            const LAS bf16* up = L0 + c;
#pragma unroll
            for (int j = 0; j < 46; ++j) { const float uv = bf2f(up[j * 1024]);
#pragma unroll
                for (int i = 0; i < 16; ++i) if (j - i >= 0 && j - i <= 30) a[i] += w[j - i] * uv; }
#pragma unroll
            for (int i = 0; i < 16; ++i) { ya[cc][i] = a[i]; st[i] += a[i]; st[16 + i] += a[i] * a[i]; } }
        block_reduce<32>(st, red, wave, lane, tid);
        float s2[16];
#pragma unroll
        for (int i = 0; i < 16; ++i) { const float mean = st[i] * (1.f / 1024.f); float var = st[16 + i] * (1.f / 1024.f) - mean * mean; var = var > 0.f ? var : 0.f;
            st[i] = mean; st[16 + i] = 1.f / sqrtf(var + EPS); s2[i] = 0.f; }
#pragma unroll
        for (int cc = 0; cc < 2; ++cc) { const int c = tid + 512 * cc; const float g = ((const GAS float*)P.ln_g)[c], bb = ((const GAS float*)P.ln_b)[c];
#pragma unroll
            for (int i = 0; i < 16; ++i) { const float x = (ya[cc][i] - st[i]) * st[16 + i] * g + bb; const float s = x / (1.f + __expf(-x)); ya[cc][i] = s; s2[i] += s * s; } }
        block_reduce<16>(s2, red, wave, lane, tid);
#pragma unroll
        for (int i = 0; i < 16; ++i) s2[i] = 1.f / sqrtf(s2[i] * (1.f / 1024.f) + EPS);
#pragma unroll
        for (int cc = 0; cc < 2; ++cc) { const int c = tid + 512 * cc; const float gn = ((const GAS float*)P.gain)[c]; GAS bf16* yp = (GAS bf16*)yo + c;
#pragma unroll
            for (int i = 0; i < 16; ++i) yp[(size_t)i * DM] = (bf16)f2bf(ya[cc][i] * s2[i] * gn); }
    }
    {
        LAS bf16* Lcg = L0, *Lx = L0 + 18 * 1024, *Lbg = L0 + 36 * 1024;
        stage_rows(pj, t0 - 2, 18, C_CG, Lcg, tid); stage_rows(pj, t0 - 2, 18, C_BX, Lx, tid); stage_rows(pj, t0, 16, C_BG, Lbg, tid);
        __syncthreads();
        float yb[2][16], s2[16];
#pragma unroll
        for (int i = 0; i < 16; ++i) s2[i] = 0.f;
#pragma unroll
        for (int cc = 0; cc < 2; ++cc) { const int c = tid + 512 * cc;
            const float w0 = ((const GAS float*)P.sconv_w)[c], w1 = ((const GAS float*)P.sconv_w)[1024 + c], w2 = ((const GAS float*)P.sconv_w)[2048 + c];
            float g[18];
#pragma unroll
            for (int j = 0; j < 18; ++j) g[j] = bf2f(Lcg[j * 1024 + c]) * bf2f(Lx[j * 1024 + c]);
#pragma unroll
            for (int i = 0; i < 16; ++i) { const float bg = bf2f(Lbg[i * 1024 + c]);
                const float v = bg * (w0 * g[i] + w1 * g[i + 1] + w2 * g[i + 2]); yb[cc][i] = v; s2[i] += v * v; } }
        block_reduce<16>(s2, red, wave, lane, tid);
#pragma unroll
        for (int i = 0; i < 16; ++i) s2[i] = 1.f / sqrtf(s2[i] * (1.f / 1024.f) + EPS);
#pragma unroll
        for (int cc = 0; cc < 2; ++cc) { const int c = tid + 512 * cc; const float gn = ((const GAS float*)P.gain)[1024 + c]; GAS bf16* yp = (GAS bf16*)yo + 1024 + c;
#pragma unroll
            for (int i = 0; i < 16; ++i) yp[(size_t)i * DM] = (bf16)f2bf(yb[cc][i] * s2[i] * gn); }
    }
    {
        stage_rows(pj, t0 - 15, 31, C_D, L0, tid);
        __syncthreads();
        float yd[2][16], s2[16];
#pragma unroll
        for (int i = 0; i < 16; ++i) s2[i] = 0.f;
#pragma unroll
        for (int cc = 0; cc < 2; ++cc) { const int c = tid + 512 * cc; const int gi = (wave >> 2) + 2 * cc; const int w = 2 << gi; const float ps = ((const GAS float*)P.pool_scale)[c];
            float z[31];
#pragma unroll
            for (int j = 0; j < 31; ++j) z[j] = bf2f(L0[j * 1024 + c]);
#pragma unroll
            for (int i = 0; i < 16; ++i) { float s = 0.f;
#pragma unroll
                for (int m = 0; m < 16; ++m) if (m < w) s += z[15 + i - m];
                const int tt = t0 + i; const int cnt = (tt + 1 < w) ? (tt + 1) : w;
                const float v = (s / (float)cnt - z[15 + i]) * ps; yd[cc][i] = v; s2[i] += v * v; } }
        block_reduce<16>(s2, red, wave, lane, tid);
#pragma unroll
        for (int i = 0; i < 16; ++i) s2[i] = 1.f / sqrtf(s2[i] * (1.f / 1024.f) + EPS);
#pragma unroll
        for (int cc = 0; cc < 2; ++cc) { const int c = tid + 512 * cc; const float gn = ((const GAS float*)P.gain)[3072 + c]; GAS bf16* yp = (GAS bf16*)yo + 3072 + c;
#pragma unroll
            for (int i = 0; i < 16; ++i) yp[(size_t)i * DM] = (bf16)f2bf(yd[cc][i] * s2[i] * gn); }
    }
}

__device__ __forceinline__ void mix_attn_tile(Frame& F, const MixP& P, int tile, LAS unsigned char* lds) {
    constexpr int KSP = 72, VTP = 200;
    LAS bf16* Ks = (LAS bf16*)lds;
    LAS bf16* Vt = (LAS bf16*)(lds + 55296);
    LAS float* ssq = (LAS float*)(lds + 55296 + 51200 + 256);
    LAS float* rsq = ssq + 1024;
    const int lane = fresh_lane(), wave = F.wave, tid = wave * 64 + lane;
    const int b = tile >> 7, t0 = (tile & 127) * 64;
    const bf16* pj = P.proj + (size_t)b * SEQ * INC;
    bf16* yo = P.Y + ((size_t)b * SEQ + t0) * DM + 2048;
#pragma unroll
    for (int r = 0; r < 6; ++r) { const int q = tid + 512 * r; const int kvh = q / 1536; const int rem = q - kvh * 1536; const int key = rem >> 3, dc = rem & 7; const int t = t0 - 128 + key;
        v4u kv = (v4u){0u, 0u, 0u, 0u}, vv = (v4u){0u, 0u, 0u, 0u};
        if (t >= 0) { const bf16* row = pj + (size_t)t * INC; kv = *(const GAS v4u*)(row + C_K + kvh * 64 + dc * 8); vv = *(const GAS v4u*)(row + C_V + kvh * 64 + dc * 8); }
        *(LAS v4u*)(Ks + (kvh * 192 + key) * KSP + dc * 8) = kv;
        const unsigned vw[4] = {vv.x, vv.y, vv.z, vv.w};
#pragma unroll
        for (int e = 0; e < 8; ++e) Vt[(kvh * 64 + dc * 8 + e) * VTP + key] = (bf16)((e & 1) ? (vw[e >> 1] >> 16) : (vw[e >> 1] & 0xffffu)); }
    __syncthreads();
    const int fr = lane & 15, fq = lane >> 4, kvh = wave >> 2;
#pragma unroll 1
    for (int hh = 0; hh < 2; ++hh) {
        const int head = wave * 2 + hh;
        const float slope = exp2f(-0.5f * (float)(head + 1)), sink = ((const GAS float*)P.sinks)[head];
#pragma unroll 1
        for (int qs = 0; qs < 4; ++qs) {
            const bf16* qrow = pj + (size_t)(t0 + 16 * qs + fr) * INC + C_Q + head * 64 + fq * 8;
            const bf16x8 q0 = *(const GAS bf16x8*)qrow, q1 = *(const GAS bf16x8*)(qrow + 32);
            f32x4 s[9];
#pragma unroll
            for (int j = 0; j < 9; ++j) { const LAS bf16* kp = Ks + (kvh * 192 + (qs + j) * 16 + fr) * KSP + fq * 8;
                const bf16x8 k0 = *(const LAS bf16x8*)kp, k1 = *(const LAS bf16x8*)(kp + 32);
                f32x4 a = (f32x4){0.f, 0.f, 0.f, 0.f};
                a = __builtin_amdgcn_mfma_f32_16x16x32_bf16(k0, q0, a, 0, 0, 0); a = __builtin_amdgcn_mfma_f32_16x16x32_bf16(k1, q1, a, 0, 0, 0); s[j] = a; }
            float mx = -3.0e38f;
#pragma unroll
            for (int j = 0; j < 9; ++j)
#pragma unroll
                for (int i = 0; i < 4; ++i) { const int dist = 128 + fr - 16 * j - 4 * fq - i; const int kr = (qs + j) * 16 + 4 * fq + i;
                    const bool valid = (dist >= 0) && (dist < 128) && (t0 - 128 + kr >= 0);
                    const float sc = valid ? (s[j][i] * 0.125f - slope * (float)dist) : -1e30f; s[j][i] = sc; mx = fmaxf(mx, sc); }
            mx = fmaxf(mx, __shfl_xor(mx, 16)); mx = fmaxf(mx, __shfl_xor(mx, 32));
            const float mm = fmaxf(mx, sink);
            float l = 0.f;
#pragma unroll
            for (int j = 0; j < 9; ++j)
#pragma unroll
                for (int i = 0; i < 4; ++i) { const float p = __expf(s[j][i] - mm); s[j][i] = p; l += p; }
            l += __shfl_xor(l, 16); l += __shfl_xor(l, 32);
            l += __expf(sink - mm);
            const float inv = 1.f / l;
            unsigned pk[9][2];
#pragma unroll
            for (int j = 0; j < 9; ++j) { pk[j][0] = pk2(s[j][0], s[j][1]); pk[j][1] = pk2(s[j][2], s[j][3]); }
            f32x4 o[4];
#pragma unroll
            for (int dt = 0; dt < 4; ++dt) o[dt] = (f32x4){0.f, 0.f, 0.f, 0.f};
#pragma unroll
            for (int kp = 0; kp < 5; ++kp) { const int j0 = 2 * kp, j1 = (kp == 4) ? 8 : 2 * kp + 1;
                v4u bw; bw.x = pk[j0][0]; bw.y = pk[j0][1]; bw.z = (kp == 4) ? 0u : pk[j1][0]; bw.w = (kp == 4) ? 0u : pk[j1][1];
                const bf16x8 bop = __builtin_bit_cast(bf16x8, bw);
#pragma unroll
                for (int dt = 0; dt < 4; ++dt) { const LAS bf16* vp = Vt + (kvh * 64 + dt * 16 + fr) * VTP + 4 * fq;
                    const v2u lo = *(const LAS v2u*)(vp + (qs + j0) * 16), hi = *(const LAS v2u*)(vp + (qs + j1) * 16);
                    const v4u aw = (v4u){lo.x, lo.y, hi.x, hi.y};
                    o[dt] = __builtin_amdgcn_mfma_f32_16x16x32_bf16(__builtin_bit_cast(bf16x8, aw), bop, o[dt], 0, 0, 0); } }
            float sq = 0.f;
#pragma unroll
            for (int dt = 0; dt < 4; ++dt) { o[dt] = o[dt] * inv; sq += (o[dt].x * o[dt].x + o[dt].y * o[dt].y) + (o[dt].z * o[dt].z + o[dt].w * o[dt].w);
                v2u w2; w2.x = pk2(o[dt].x, o[dt].y); w2.y = pk2(o[dt].z, o[dt].w);
                *(GAS v2u*)(yo + (size_t)(16 * qs + fr) * DM + head * 64 + dt * 16 + 4 * fq) = w2; }
            sq += __shfl_xor(sq, 16); sq += __shfl_xor(sq, 32);
            if (fq == 0) ssq[head * 64 + 16 * qs + fr] = sq;
        }
    }
    __syncthreads();
    if (tid < 64) { float s = 0.f;
#pragma unroll
        for (int h = 0; h < 16; ++h) s += ssq[h * 64 + tid];
        rsq[tid] = 1.f / sqrtf(s * (1.f / 1024.f) + EPS); }
    __syncthreads();
#pragma unroll 4
    for (int r = 0; r < 16; ++r) { const int ch = tid + 512 * r; const int q = ch >> 7, cc = (ch & 127) * 8;
        GAS bf16* p = (GAS bf16*)yo + (size_t)q * DM + cc; const v4u w = *(const GAS v4u*)p; const float rs = rsq[q];
        const f32x4 g0 = *(const GAS f32x4*)(P.gain + 2048 + cc), g1 = *(const GAS f32x4*)(P.gain + 2048 + cc + 4);
        v4u o; o.x = pk2(bflo(w.x) * rs * g0.x, bfhi(w.x) * rs * g0.y); o.y = pk2(bflo(w.y) * rs * g0.z, bfhi(w.y) * rs * g0.w);
        o.z = pk2(bflo(w.z) * rs * g1.x, bfhi(w.z) * rs * g1.y); o.w = pk2(bflo(w.w) * rs * g1.z, bfhi(w.w) * rs * g1.w);
        *(GAS v4u*)p = o; }
    __syncthreads();
}

struct Args { const float* in[20]; float* out; unsigned char* ws; int ph_lo, ph_hi; };
typedef __attribute__((address_space(4))) const unsigned char* kargp;
__device__ __forceinline__ const float* INP(int i) { kargp k = (kargp)__builtin_amdgcn_kernarg_segment_ptr(); asm volatile("" : "+s"(k)); return (const float*)(*(__attribute__((address_space(4))) const unsigned long long*)(k + 8 * i)); }

__global__ void __launch_bounds__(NWAVES * 64, 2) mk_fwd(Args args) {
    extern __shared__ __attribute__((aligned(16))) unsigned char lds[];
    Frame F;
    F.lds = (LAS unsigned char*)lds;
    F.MISC = (volatile LAS unsigned*)(F.lds + MISC_OFF);
    F.wave = __builtin_amdgcn_readfirstlane((int)threadIdx.x >> 6);
    F.G = gridDim.x; { const int bx = blockIdx.x; F.vcu = (F.G % 8 == 0) ? (bx % 8) * (F.G / 8) + bx / 8 : bx; }
#define WS_ ((unsigned char*)INP(21))
#define H_ ((float*)(WS_ + WS_H))
#define XN_ ((bf16*)(WS_ + WS_XN))
#define PP_ ((bf16*)(WS_ + WS_PP))
#define PROJ_ ((bf16*)(WS_ + WS_BIG))
#define Y_ ((bf16*)(WS_ + WS_Y))
#define UP_ ((bf16*)(WS_ + WS_BIG))
#define XN2_ ((bf16*)(WS_ + WS_XN2))
#define SLOT_ ((float*)(WS_ + WS_SLOT))
#define RSTD_ ((float*)(WS_ + WS_RSTD))
#define TAB_ (F.lds + LDSCTL_OFF + 512)
#define WL_(L, off) ((const bf16*)(WS_ + WS_W + (size_t)(L) * W_LAYER + (off)))
    F.ctl = (gu32*)(WS_ + WS_CTL);
    for (int u = threadIdx.x; u < (LDS_BYTES - LDSCTL_OFF) / 4; u += NWAVES * 64) ((LAS unsigned*)(F.lds + LDSCTL_OFF))[u] = 0u;
    __syncthreads();
    (void)xcd_barrier_post((unsigned*)(WS_ + WS_CTL) + CW_BAR, F.MISC + 8);
#define IN(k) true
#define SEAM(k) do { if (IN(k) && IN((k) + 1)) { XcdBarrier b_; b_.bar = (unsigned*)(WS_ + WS_CTL) + CW_BAR; b_.x = xb_xcc_id(); b_.st = F.MISC + 8; xcd_barrier(b_, (F.wave == 0) && (fresh_lane() == 0)); } } while (0)

    if (IN(0)) { ProIn I{INP(1), INP(3), INP(10), INP(13), INP(15), INP(16), INP(17), INP(18), INP(4), WS_}; prologue(F, I); }
    SEAM(0);
#pragma unroll
    for (int L = 0; L < DEPTH; ++L) {
        const int pb = 1 + 8 * L;
        if (L == 0) { if (IN(pb + 0)) norm_phase(F, INP(0), INP(2), XN_, nullptr);
            SEAM(pb + 0); }
        if (IN(pb + 1)) { pg8::Gemm g{(L == 0) ? XN_ : XN2_, WL_(L, WO_IN), M, INC, DM}; pg8::StaticOrder S; S.init(M, INC, F.G, (int)blockIdx.x);
            if (L != 0) pg8::build_rstd_tab(TAB_, S, SLOT_, F.wave * 64 + fresh_lane());
            pg8::EpiBf16<0> E{PROJ_, INC, (L == 0) ? nullptr : (const float*)SLOT_, TAB_}; pg8::gemm_phase<pg8::EpiBf16<0>, pg8::StaticOrder, true, true>(F.lds, g, S, E, F.wave);
            __syncthreads();
            { const int c0 = ((M / 256) * (INC / 256)) % F.G;
              if ((int)blockIdx.x >= c0) { pg8::Gemm g2{WL_(L, WO_PB), WL_(L, WO_P), M, DM, PLE}; pg8::StaticOrder S2; S2.init(M, DM, F.G - c0, (int)blockIdx.x - c0);
                pg8::EpiBf16<0> E2{PP_, DM, nullptr, TAB_}; pg8::gemm_phase<pg8::EpiBf16<0>, pg8::StaticOrder, true, true>(F.lds, g2, S2, E2, F.wave); } } }
        SEAM(pb + 1);
        if (IN(pb + 2)) {
            MixP P{PROJ_, Y_, (const float*)(WS_ + WS_CWT) + (size_t)L * 32 * 1024, INP(5) + (size_t)L * 1024, INP(6) + (size_t)L * 1024, INP(7) + (size_t)L * 1024,
                   INP(8) + (size_t)L * 3 * 1024, INP(9) + (size_t)L * 16, INP(11) + (size_t)L * 1024, INP(12) + (size_t)L * DM};
            for (int tile = F.vcu; tile < BATCH * SEQ / 64; tile += F.G) mix_attn_tile(F, P, tile, F.lds);
            for (int tile = F.vcu; tile < BATCH * SEQ / 16; tile += F.G) mix_abd_tile(F, P, tile, F.lds);
        }
        SEAM(pb + 2);
        if (IN(pb + 3)) { pg8::Gemm g{Y_, WL_(L, WO_OUT), M, DM, DM}; pg8::StaticOrder S; S.init(M, DM, F.G, (int)blockIdx.x);
            pg8::EpiRes E{(L == 0) ? INP(0) : (const float*)H_, H_, XN_, DM, INP(14) + (size_t)L * DM, SLOT_}; pg8::gemm_phase<pg8::EpiRes, pg8::StaticOrder, true, true>(F.lds, g, S, E, F.wave); }
        SEAM(pb + 3);
        if (IN(pb + 5)) { pg8::Gemm g{XN_, WL_(L, WO_UP), M, FF, DM}; pg8::StaticOrder S; S.init(M, FF, F.G, (int)blockIdx.x);
            pg8::build_rstd_tab(TAB_, S, SLOT_, F.wave * 64 + fresh_lane());
            pg8::EpiBf16<2> E{UP_, FF, SLOT_, TAB_}; pg8::gemm_phase<pg8::EpiBf16<2>, pg8::StaticOrder, true, true>(F.lds, g, S, E, F.wave); }
        SEAM(pb + 5);
        if (IN(pb + 6)) {
            { pg8::Gemm g{UP_, WL_(L, WO_DOWN), M, DM, FF}; pg8::StaticOrder S; S.init(M, DM, F.G, (int)blockIdx.x);
              pg8::EpiRes E{H_, H_, XN_, DM, nullptr, nullptr}; pg8::gemm_phase<pg8::EpiRes, pg8::StaticOrder, true, true>(F.lds, g, S, E, F.wave); }
        }
        SEAM(pb + 6);
        if (IN(pb + 7)) { pg8::Gemm g{XN_, WL_(L, WO_G), M, DM, DM}; pg8::StaticOrder S; S.init(M, DM, F.G, (int)blockIdx.x);
            pg8::EpiGate E{H_, PP_, DM, (L + 1 < DEPTH) ? XN2_ : nullptr, INP(2) + (size_t)(L + 1 < DEPTH ? L + 1 : 0) * DM, SLOT_}; pg8::gemm_phase<pg8::EpiGate, pg8::StaticOrder, true, true>(F.lds, g, S, E, F.wave); }
        SEAM(pb + 7);
    }
    if (IN(17)) norm_phase(F, H_, INP(19), nullptr, (float*)INP(20));
#undef IN
#undef SEAM
}

extern "C" void kernel_launch(void* const* d_in, const int* in_sizes, int n_in, void* d_out, int out_size, void* d_ws, size_t ws_size, hipStream_t stream) {
    static int grid = 0;
    if (grid == 0) {
        if (n_in != 20 || in_sizes[0] != M * DM || out_size != M * DM || ws_size < WS_END) { fprintf(stderr, "kernel_launch: unexpected shapes (n_in %d, in0 %d, out %d, ws %zu); nothing launched\n", n_in, n_in > 0 ? in_sizes[0] : -1, out_size, ws_size); grid = -1; return; }
        int dev = 0, cus = 0, per_cu = 0;
        if (hipGetDevice(&dev) != hipSuccess || hipDeviceGetAttribute(&cus, hipDeviceAttributeMultiprocessorCount, dev) != hipSuccess) { grid = -1; return; }
        if (hipFuncSetAttribute((const void*)mk_fwd, hipFuncAttributeMaxDynamicSharedMemorySize, LDS_BYTES) != hipSuccess) { fprintf(stderr, "kernel_launch: hipFuncSetAttribute failed\n"); grid = -1; return; }
        if (hipOccupancyMaxActiveBlocksPerMultiprocessor(&per_cu, (const void*)mk_fwd, NWAVES * 64, LDS_BYTES) != hipSuccess || per_cu < 1)
            fprintf(stderr, "kernel_launch: note: occupancy query reports %d workgroups per CU\n", per_cu);
        (void)hipGetLastError();
        grid = cus;
    }
    if (grid < 0) return;
    if (hipMemsetAsync((char*)d_ws + WS_CTL, 0, CTL_ZERO_BYTES, stream) != hipSuccess) return;
    Args a{};
    for (int i = 0; i < 20; ++i) a.in[i] = (const float*)d_in[i];
    a.out = (float*)d_out; a.ws = (unsigned char*)d_ws;
#if MK_N_LAUNCHES == 1
    a.ph_lo = 0; a.ph_hi = N_PHASES;
    hipLaunchKernelGGL(mk_fwd, dim3(grid), dim3(NWAVES * 64), LDS_BYTES, stream, a);
#else
#error single launch only
#endif
    const hipError_t le = hipPeekAtLastError();
    if (le != hipSuccess) fprintf(stderr, "kernel_launch: launch failed: %s\n", hipGetErrorName(le));
}
```

```cpp
#include <hip/hip_runtime.h>
#include <cstdio>
#include <cstdint>
namespace pg8 {
#define PG8_LAS __attribute__((address_space(3)))
typedef unsigned short bf16_t;
typedef short bf16x8 __attribute__((ext_vector_type(8)));
typedef float f32x4 __attribute__((ext_vector_type(4)));
typedef unsigned u32x4 __attribute__((ext_vector_type(4)));
constexpr int BM = 256, BK = 64, HALF = 128, HTB = HALF * BK * 2  , STAGE_BYTES = 8 * HTB, NXCD = 8, WGM = 8;

__host__ __device__ __forceinline__ int lds_byte(int r, int c) { const int st = (r >> 4) * 2 + (c >> 5), rr = r & 15, cc = c & 31, ob = rr * 64 + cc * 2; return st * 1024 + (ob ^ (((ob >> 9) & 1) << 5)); }
__host__ __device__ __forceinline__ void stage_rc(int b, int& R, int& C) { const int st = b / 1024, sb = b % 1024, swz = sb ^ (((sb >> 9) & 1) << 5); R = (st >> 1) * 16 + swz / 64; C = (st & 1) * 32 + (swz % 64) / 2; }
__host__ __device__ __forceinline__ int perm32(int rho) { const int n = rho >> 4, i = rho & 15; return 8 * (i >> 2) + 4 * n + (i & 3); }

struct Unit { int pm, pn; };
struct Gemm { const bf16_t* A; const bf16_t* Bt; int M, N, K; };

struct StaticOrder {
    int nM, nN, nwg, G, c;
    __host__ __device__ void init(int M, int N, int G_, int c_) { nM = M / BM; nN = N / BM; nwg = nM * nN; G = G_; c = c_; }
    __host__ __device__ bool next(int i, Unit& u) const {
        const long L = (long)i * G + c; if (L >= nwg) return false;
        int wgid = (int)L; { const int q = nwg / NXCD, r = nwg % NXCD, xcd = wgid % NXCD, off = wgid / NXCD; wgid = (xcd < r ? xcd * (q + 1) : r * (q + 1) + (xcd - r) * q) + off; }
        const int nig = WGM * nN, gid = wgid / nig, fm = gid * WGM, gsz = (nM - fm) < WGM ? (nM - fm) : WGM;
        u.pm = fm + ((wgid % nig) % gsz); u.pn = (wgid % nig) / gsz; return true;
    }
    __device__ __forceinline__ void a_ready(const Unit&) const {}
    __device__ __forceinline__ void done(const Unit&) const {}
};
__device__ __forceinline__ unsigned cvt_pk_bf16(float lo, float hi) { unsigned r; asm volatile("v_cvt_pk_bf16_f32 %0, %1, %2" : "=v"(r) : "v"(lo), "v"(hi)); return r; }
typedef float f32x2 __attribute__((ext_vector_type(2)));
#define EGAS __attribute__((address_space(1)))
template <int ACT  > struct EpiBf16 {
    static constexpr bool PERM = true, AFTER_DRAIN = false;
    bf16_t* O; int ldc; const float* slots; PG8_LAS unsigned char* tab;
    __device__ __forceinline__ void operator()(const f32x4 (&acc)[2][2][4][2], const Unit& u, int wr, int wc, int fr, int fq) const {
        const int row0 = u.pm * BM + wr * 64 + fr, col0 = u.pn * BM + wc * 32 + 8 * fq;
        int sl = -1;
        if (slots) {
#pragma unroll
            for (int s = 0; s < 8; ++s) if (((const PG8_LAS int*)tab)[s] == u.pm) sl = s; }
#pragma unroll
        for (int ai = 0; ai < 2; ++ai)
#pragma unroll
            for (int m = 0; m < 4; ++m) { EGAS bf16_t* rowp = (EGAS bf16_t*)O + (size_t)(row0 + ai * HALF + m * 16) * ldc + col0;
                float rs = 1.f;
                if (slots) { const int rl = wr * 64 + fr + ai * HALF + m * 16;
                    if (sl >= 0) rs = ((const PG8_LAS float*)(tab + 32))[sl * 256 + rl];
                    else { const EGAS f32x4* sp = (const EGAS f32x4*)(slots + (size_t)(u.pm * BM + rl) * 64); float a = 0.f;
#pragma unroll 1
                        for (int j = 0; j < 16; ++j) { const f32x4 v = sp[j]; a += (v[0] + v[1]) + (v[2] + v[3]); }
                        rs = 1.f / sqrtf(a * (1.f / 4096.f) + 1e-6f); } }
#pragma unroll
                for (int bj = 0; bj < 2; ++bj) { f32x4 v0 = acc[ai][bj][m][0] * rs, v1 = acc[ai][bj][m][1] * rs;
                    if (ACT == 2) {
#pragma unroll
                        for (int e = 0; e < 4; ++e) { float a = v0[e] > 0.f ? v0[e] : 0.f; v0[e] = a * a; float b = v1[e] > 0.f ? v1[e] : 0.f; v1[e] = b * b; } }
                    u32x4 w; w.x = cvt_pk_bf16(v0[0], v0[1]); w.y = cvt_pk_bf16(v0[2], v0[3]); w.z = cvt_pk_bf16(v1[0], v1[1]); w.w = cvt_pk_bf16(v1[2], v1[3]);
                    *(EGAS u32x4*)(rowp + bj * HALF) = w; } }
    }
};
struct EpiRes {
    static constexpr bool PERM = true, AFTER_DRAIN = false;
    const float* res; float* out; bf16_t* hb; int ld; const float* gain; float* slots;
    __device__ __forceinline__ void operator()(const f32x4 (&acc)[2][2][4][2], const Unit& u, int wr, int wc, int fr, int fq) const {
        const int row0 = u.pm * BM + wr * 64 + fr, col0 = u.pn * BM + wc * 32 + 8 * fq;
        f32x4 gv[2][2];
#pragma unroll
        for (int bj = 0; bj < 2; ++bj)
#pragma unroll
            for (int n = 0; n < 2; ++n) gv[bj][n] = gain ? *(const EGAS f32x4*)(gain + col0 + bj * HALF + 4 * n) : (f32x4){1.f, 1.f, 1.f, 1.f};
#pragma unroll
        for (int ai = 0; ai < 2; ++ai)
#pragma unroll
            for (int m = 0; m < 4; ++m) { const int row = row0 + ai * HALF + m * 16; const size_t off = (size_t)row * ld + col0; float ss = 0.f;
#pragma unroll
                for (int bj = 0; bj < 2; ++bj) {
                    const f32x4 r0 = *(const EGAS f32x4*)(res + off + bj * HALF), r1 = *(const EGAS f32x4*)(res + off + bj * HALF + 4);
                    const f32x4 v0 = acc[ai][bj][m][0] + r0, v1 = acc[ai][bj][m][1] + r1;
                    *(EGAS f32x4*)(out + off + bj * HALF) = v0; *(EGAS f32x4*)(out + off + bj * HALF + 4) = v1;
                    ss += (v0[0] * v0[0] + v0[1] * v0[1]) + (v0[2] * v0[2] + v0[3] * v0[3]) + (v1[0] * v1[0] + v1[1] * v1[1]) + (v1[2] * v1[2] + v1[3] * v1[3]);
                    if (hb) { const f32x4 s0 = v0 * gv[bj][0], s1 = v1 * gv[bj][1];
                        u32x4 w; w.x = cvt_pk_bf16(s0[0], s0[1]); w.y = cvt_pk_bf16(s0[2], s0[3]); w.z = cvt_pk_bf16(s1[0], s1[1]); w.w = cvt_pk_bf16(s1[2], s1[3]);
                        *(EGAS u32x4*)(hb + off + bj * HALF) = w; } }
                if (slots) { ss += __shfl_xor(ss, 16); ss += __shfl_xor(ss, 32); if (fq == 0) ((EGAS float*)slots)[(size_t)row * 64 + u.pn * 4 + wc] = ss; } }
    }
};
struct EpiGate {
    static constexpr bool PERM = true, AFTER_DRAIN = false;
    float* h; const bf16_t* pp; int ld; bf16_t* hb; const float* gain; float* slots;
    __device__ __forceinline__ void operator()(const f32x4 (&acc)[2][2][4][2], const Unit& u, int wr, int wc, int fr, int fq) const {
        const int row0 = u.pm * BM + wr * 64 + fr, col0 = u.pn * BM + wc * 32 + 8 * fq;
        f32x4 gv[2][2];
#pragma unroll
        for (int bj = 0; bj < 2; ++bj)
#pragma unroll
            for (int n = 0; n < 2; ++n) gv[bj][n] = hb ? *(const EGAS f32x4*)(gain + col0 + bj * HALF + 4 * n) : (f32x4){1.f, 1.f, 1.f, 1.f};
#pragma unroll
        for (int ai = 0; ai < 2; ++ai)
#pragma unroll
            for (int m = 0; m < 4; ++m) { const int row = row0 + ai * HALF + m * 16; const size_t off = (size_t)row * ld + col0; float ss = 0.f;
#pragma unroll
                for (int bj = 0; bj < 2; ++bj) {
                    f32x4 r0 = *(const EGAS f32x4*)(h + off + bj * HALF), r1 = *(const EGAS f32x4*)(h + off + bj * HALF + 4);
                    const u32x4 pw = *(const EGAS u32x4*)(pp + off + bj * HALF);
                    const f32x4 a0 = acc[ai][bj][m][0], a1 = acc[ai][bj][m][1];
                    const unsigned pwv[4] = {pw.x, pw.y, pw.z, pw.w};
#pragma unroll
                    for (int e = 0; e < 4; ++e) {
                        const float p0 = __builtin_bit_cast(float, (e & 1) ? (pwv[e >> 1] & 0xffff0000u) : (pwv[e >> 1] << 16));
                        const float p1 = __builtin_bit_cast(float, (e & 1) ? (pwv[2 + (e >> 1)] & 0xffff0000u) : (pwv[2 + (e >> 1)] << 16));
                        r0[e] += p0 / (1.f + __expf(-a0[e])); r1[e] += p1 / (1.f + __expf(-a1[e])); }
                    *(EGAS f32x4*)(h + off + bj * HALF) = r0; *(EGAS f32x4*)(h + off + bj * HALF + 4) = r1;
                    if (hb) { ss += (r0[0] * r0[0] + r0[1] * r0[1]) + (r0[2] * r0[2] + r0[3] * r0[3]) + (r1[0] * r1[0] + r1[1] * r1[1]) + (r1[2] * r1[2] + r1[3] * r1[3]);
                        const f32x4 s0 = r0 * gv[bj][0], s1 = r1 * gv[bj][1];
                        u32x4 w; w.x = cvt_pk_bf16(s0[0], s0[1]); w.y = cvt_pk_bf16(s0[2], s0[3]); w.z = cvt_pk_bf16(s1[0], s1[1]); w.w = cvt_pk_bf16(s1[2], s1[3]);
                        *(EGAS u32x4*)(hb + off + bj * HALF) = w; } }
                if (hb) { ss += __shfl_xor(ss, 16); ss += __shfl_xor(ss, 32); if (fq == 0) ((EGAS float*)slots)[(size_t)row * 64 + u.pn * 4 + wc] = ss; } }
    }
};
template <class Sched> __device__ __forceinline__ void build_rstd_tab(PG8_LAS unsigned char* tab, const Sched& S, const float* slots, int tid) {
    PG8_LAS int* pmid = (PG8_LAS int*)tab; PG8_LAS float* rs = (PG8_LAS float*)(tab + 32);
    if (tid == 0) { int n = 0;
        for (int s = 0; s < 8; ++s) pmid[s] = -1;
        Unit u; for (int i = 0; S.next(i, u); ++i) { bool f = false; for (int s = 0; s < 8; ++s) f |= (pmid[s] == u.pm); if (!f && n < 8) { pmid[n] = u.pm; ++n; } } }
    __syncthreads();
    for (int e = tid; e < 8 * 256; e += 512) { const int s = e >> 8, r = e & 255; const int pm = pmid[s];
        if (pm >= 0) { const EGAS f32x4* sp = (const EGAS f32x4*)(slots + (size_t)(pm * BM + r) * 64); float a = 0.f;
#pragma unroll
            for (int j = 0; j < 16; ++j) { const f32x4 v = sp[j]; a += (v[0] + v[1]) + (v[2] + v[3]); }
            rs[e] = 1.f / sqrtf(a * (1.f / 4096.f) + 1e-6f); } }
    __syncthreads();
}
struct TailOrder {
    int nN, nwg, G2, c2;
    __device__ void init(int M, int N, int G, int c, int c0) { nN = N / BM; nwg = (M / BM) * nN; G2 = G - c0; c2 = c - c0; }
    __device__ bool next(int i, Unit& u) const { if (c2 < 0) return false; const int L = i * G2 + c2; if (L >= nwg) return false; u.pm = L / nN; u.pn = L - u.pm * nN; return true; }
    __device__ __forceinline__ void a_ready(const Unit&) const {}
    __device__ __forceinline__ void done(const Unit&) const {}
};
template <class Epi, class Sched, bool ALIGN_EPI = false, bool SP2 = false>
__device__ __forceinline__ void gemm_phase(PG8_LAS unsigned char* lds, const Gemm g, const Sched& S, const Epi& E, const int wave_in) {
    int lane; asm volatile("v_mbcnt_lo_u32_b32 %0, -1, 0\n\tv_mbcnt_hi_u32_b32 %0, -1, %0" : "=v"(lane));
    const int wid = wave_in, tid = wid * 64 + lane, wr = wid >> 2, wc = wid & 3, fr = lane & 15, fq = lane >> 4;
    const int K = g.K, nt = K / BK;
    unsigned voffA[2], voffB[2];
#pragma unroll
    for (int i = 0; i < 2; ++i) { int R, C; stage_rc(tid * 16 + i * 8192, R, C); const int Rb = Epi::PERM ? ((R & ~31) + perm32(R & 31)) : R;
        voffA[i] = (unsigned)(R * K + C) * 2u; voffB[i] = (unsigned)(Rb * K + C) * 2u; }
    const size_t kstep = (size_t)(BK * 2);
    const size_t hstep = (size_t)HALF * K * 2;
    const size_t tstep = 2 * hstep;
    const unsigned ldsw = (unsigned)wid * 1024u;
    const int aoff = lds_byte(wr * 64 + fr, fq * 8), boff = lds_byte(wc * 32 + fr, fq * 8);
#define PG8_SA(b, h) (((b) * 2 + (h)) * HTB)
#define PG8_SB(b, h) ((4 + (b) * 2 + (h)) * HTB)
#define PG8_STAGE(bufoff, gbase, voff) do { _Pragma("unroll") for (int _i = 0; _i < 2; ++_i) \
        __builtin_amdgcn_global_load_lds((const unsigned*)((const char*)(gbase) + (voff)[_i]), (PG8_LAS unsigned*)(lds + (bufoff) + ldsw + _i * 8192), 16, 0, 0); } while (0)
#define PG8_LDA(dst, b, h) do { _Pragma("unroll") for (int m = 0; m < 4; ++m) _Pragma("unroll") for (int k = 0; k < 2; ++k) dst[m][k] = *(const PG8_LAS bf16x8*)(lds + PG8_SA(b, h) + aoff + m * 2048 + k * 1024); } while (0)
#define PG8_LDB(dst, b, h) do { _Pragma("unroll") for (int n = 0; n < 2; ++n) _Pragma("unroll") for (int k = 0; k < 2; ++k) dst[n][k] = *(const PG8_LAS bf16x8*)(lds + PG8_SB(b, h) + boff + n * 2048 + k * 1024); } while (0)
#define PG8_MMA(ai, bj, At, Bt) do { __builtin_amdgcn_s_setprio(1); _Pragma("unroll") for (int m = 0; m < 4; ++m) _Pragma("unroll") for (int n = 0; n < 2; ++n) _Pragma("unroll") for (int k = 0; k < 2; ++k) \
        acc[ai][bj][m][n] = __builtin_amdgcn_mfma_f32_16x16x32_bf16(Bt[n][k], At[m][k], acc[ai][bj][m][n], 0, 0, 0); __builtin_amdgcn_s_setprio(0); } while (0)
#define PG8_WAIT_V(n) asm volatile("s_waitcnt vmcnt(" #n ")" ::: "memory")
#define PG8_WAIT_L(n) asm volatile("s_waitcnt lgkmcnt(" #n ")" ::: "memory")
#define PG8_BAR __builtin_amdgcn_s_barrier()
#define PG8_SCHED __builtin_amdgcn_sched_barrier(0)
    Unit cur, nxt; int ui = 0;
    if (!S.next(0, cur)) return;
    f32x4 acc[2][2][4][2];
#pragma unroll
    for (int a = 0; a < 2; ++a)
#pragma unroll
        for (int b = 0; b < 2; ++b)
#pragma unroll
            for (int m = 0; m < 4; ++m)
#pragma unroll
                for (int n = 0; n < 2; ++n) acc[a][b][m][n] = (f32x4){0.f, 0.f, 0.f, 0.f};
    bf16x8 At[4][2], B0[2][2], B1[2][2];
    const char* cA = (const char*)g.A + (size_t)cur.pm * tstep; const char* cB = (const char*)g.Bt + (size_t)cur.pn * tstep;
    S.a_ready(cur);
    if constexpr (SP2) {
        PG8_STAGE(PG8_SB(0, 0), cB, voffB); PG8_STAGE(PG8_SB(0, 1), cB + hstep, voffB); PG8_STAGE(PG8_SA(0, 0), cA, voffA); PG8_STAGE(PG8_SA(0, 1), cA + hstep, voffA);
        if (wr == 1) PG8_BAR;
        PG8_WAIT_V(2); PG8_BAR;
        PG8_STAGE(PG8_SB(1, 0), cB + kstep, voffB); PG8_STAGE(PG8_SA(1, 0), cA + kstep, voffA); PG8_STAGE(PG8_SB(1, 1), cB + hstep + kstep, voffB);
        PG8_WAIT_V(6); PG8_BAR;
    } else {
        PG8_STAGE(PG8_SB(0, 0), cB, voffB); PG8_STAGE(PG8_SA(0, 0), cA, voffA); PG8_STAGE(PG8_SB(0, 1), cB + hstep, voffB); PG8_STAGE(PG8_SA(0, 1), cA + hstep, voffA);
        if (wr == 1) PG8_BAR;
        PG8_WAIT_V(4); PG8_BAR;
        PG8_STAGE(PG8_SB(1, 0), cB + kstep, voffB); PG8_STAGE(PG8_SA(1, 0), cA + kstep, voffA); PG8_STAGE(PG8_SB(1, 1), cB + hstep + kstep, voffB);
        PG8_WAIT_V(6); PG8_BAR;
    }
    for (;;) {
        const bool has_next = S.next(ui + 1, nxt);
        const char* nA = has_next ? (const char*)g.A + (size_t)nxt.pm * tstep : cA; const char* nB = has_next ? (const char*)g.Bt + (size_t)nxt.pn * tstep : cB;
        for (int t = 0; t < nt; t += 2) {
            const bool last = (t == nt - 2);
            const char* a1 = cA + (size_t)(t + 1) * kstep;
            const char* a2 = last ? nA : cA + (size_t)(t + 2) * kstep; const char* b2 = last ? nB : cB + (size_t)(t + 2) * kstep;
            const char* a3 = a2 + kstep; const char* b3 = b2 + kstep;
            if (last && has_next) S.a_ready(nxt);
            if constexpr (SP2) {
            PG8_LDB(B0, 0, 0); PG8_LDB(B1, 0, 1); PG8_SCHED; PG8_LDA(At, 0, 0); PG8_STAGE(PG8_SA(1, 1), a1 + hstep, voffA);
            PG8_WAIT_V(8); PG8_WAIT_L(0); PG8_BAR; PG8_MMA(0, 0, At, B0); PG8_MMA(0, 1, At, B1); PG8_BAR; PG8_SCHED;
            PG8_LDA(At, 0, 1); PG8_STAGE(PG8_SB(0, 0), b2, voffB); PG8_STAGE(PG8_SB(0, 1), b2 + hstep, voffB); PG8_STAGE(PG8_SA(0, 0), a2, voffA);
            PG8_WAIT_V(8); PG8_WAIT_L(0); PG8_BAR; PG8_MMA(1, 0, At, B0); PG8_MMA(1, 1, At, B1); PG8_BAR; PG8_SCHED;
            PG8_LDB(B0, 1, 0); PG8_LDB(B1, 1, 1); PG8_SCHED; PG8_LDA(At, 1, 0); PG8_STAGE(PG8_SA(0, 1), a2 + hstep, voffA);
            PG8_WAIT_V(8); PG8_WAIT_L(0); PG8_BAR; PG8_MMA(0, 0, At, B0); PG8_MMA(0, 1, At, B1); PG8_BAR; PG8_SCHED;
            PG8_LDA(At, 1, 1); PG8_STAGE(PG8_SB(1, 0), b3, voffB); PG8_STAGE(PG8_SB(1, 1), b3 + hstep, voffB); PG8_STAGE(PG8_SA(1, 0), a3, voffA);
            PG8_WAIT_V(8); PG8_WAIT_L(0); PG8_BAR; PG8_MMA(1, 0, At, B0); PG8_MMA(1, 1, At, B1); PG8_BAR; PG8_SCHED;
            } else {
            PG8_LDB(B0, 0, 0); PG8_SCHED; PG8_LDA(At, 0, 0); PG8_STAGE(PG8_SA(1, 1), a1 + hstep, voffA);
            PG8_WAIT_L(8); PG8_BAR; PG8_WAIT_L(0); PG8_MMA(0, 0, At, B0); PG8_BAR; PG8_SCHED;
            PG8_LDB(B1, 0, 1); PG8_STAGE(PG8_SB(0, 0), b2, voffB);
            PG8_BAR; PG8_WAIT_L(0); PG8_MMA(0, 1, At, B1); PG8_BAR;
            PG8_LDA(At, 0, 1); PG8_STAGE(PG8_SA(0, 0), a2, voffA);
            PG8_BAR; PG8_WAIT_L(0); PG8_MMA(1, 0, At, B0); PG8_BAR; PG8_SCHED;
            PG8_STAGE(PG8_SB(0, 1), b2 + hstep, voffB);
            PG8_WAIT_V(6); PG8_BAR; PG8_MMA(1, 1, At, B1); PG8_BAR;
            PG8_LDB(B0, 1, 0); PG8_SCHED; PG8_LDA(At, 1, 0); PG8_STAGE(PG8_SA(0, 1), a2 + hstep, voffA);
            PG8_WAIT_L(8); PG8_BAR; PG8_WAIT_L(0); PG8_MMA(0, 0, At, B0); PG8_BAR; PG8_SCHED;
            PG8_LDB(B1, 1, 1); PG8_STAGE(PG8_SB(1, 0), b3, voffB);
            PG8_BAR; PG8_WAIT_L(0); PG8_MMA(0, 1, At, B1); PG8_BAR;
            PG8_LDA(At, 1, 1); PG8_STAGE(PG8_SA(1, 0), a3, voffA);
            PG8_BAR; PG8_WAIT_L(0); PG8_MMA(1, 0, At, B0); PG8_BAR; PG8_SCHED;
            PG8_STAGE(PG8_SB(1, 1), b3 + hstep, voffB);
            PG8_WAIT_V(6); PG8_BAR; PG8_MMA(1, 1, At, B1); PG8_BAR;
            }
        }
        if constexpr (ALIGN_EPI) { if (wr == 0) PG8_BAR; }
        if constexpr (!Epi::AFTER_DRAIN) { E(acc, cur, wr, wc, fr, fq); S.done(cur); }
        if (!has_next) break;
#pragma unroll
        for (int a = 0; a < 2; ++a)
#pragma unroll
            for (int b = 0; b < 2; ++b)
#pragma unroll
                for (int m = 0; m < 4; ++m)
#pragma unroll
                    for (int n = 0; n < 2; ++n) acc[a][b][m][n] = (f32x4){0.f, 0.f, 0.f, 0.f};
        cur = nxt; cA = nA; cB = nB; ++ui;
        if constexpr (ALIGN_EPI) { if (wr == 1) PG8_BAR; }
    }
    PG8_WAIT_V(0);
    if constexpr (!ALIGN_EPI) { if (wr == 0) PG8_BAR; }
    PG8_BAR;
    if constexpr (Epi::AFTER_DRAIN) { E.fused(acc, cur, wr, wc, fr, fq, lds, wid, lane); S.done(cur); }
#undef PG8_SA
#undef PG8_SB
#undef PG8_STAGE
#undef PG8_LDA
#undef PG8_LDB
#undef PG8_MMA
#undef PG8_WAIT_V
#undef PG8_WAIT_L
#undef PG8_BAR
#undef PG8_SCHED
}
}
#define GAS __attribute__((address_space(1)))
#define LAS __attribute__((address_space(3)))
typedef unsigned short bf16;
typedef unsigned v4u __attribute__((ext_vector_type(4)));
typedef float f32x4 __attribute__((ext_vector_type(4)));
typedef short bf16x8 __attribute__((ext_vector_type(8)));
typedef GAS unsigned gu32;
typedef GAS unsigned long long gu64;
#define RLX_AGENT __ATOMIC_RELAXED, __HIP_MEMORY_SCOPE_AGENT
#define LDS_WAIT() asm volatile("s_waitcnt lgkmcnt(0)" ::: "memory")
#define VM_WAIT() asm volatile("s_waitcnt vmcnt(0)" ::: "memory")
__device__ __forceinline__ unsigned long long rt() { return __builtin_amdgcn_s_memrealtime(); }
__device__ __forceinline__ unsigned f2bf(float f) { unsigned u = __builtin_bit_cast(unsigned, f); return (u + 0x7fffu + ((u >> 16) & 1u)) >> 16; }
__device__ __forceinline__ unsigned pk2(float lo, float hi) { return f2bf(lo) | (f2bf(hi) << 16); }
#define XB_TMO      128
#define XB_XCNT(j)  (256  + 64 * (j))
#define XB_XSUB(j)  (1280 + 64 * (j))
#define XB_XGEN(j)  (2304 + 64 * (j))
#define XB_TOP      3328
#define XB_TOPGEN   3392
#define XCD_BAR_WORDS 3456
#define XB_SPIN_CAP (1u << 18)

__device__ __forceinline__ unsigned xb_ld(unsigned* p)              { return __hip_atomic_load(p, __ATOMIC_RELAXED, __HIP_MEMORY_SCOPE_AGENT); }
__device__ __forceinline__ unsigned xb_add(unsigned* p, unsigned v) { return __hip_atomic_fetch_add(p, v, __ATOMIC_RELAXED, __HIP_MEMORY_SCOPE_AGENT); }
__device__ __forceinline__ unsigned xb_xcc_id() { return (unsigned)__builtin_amdgcn_s_getreg((3 << 11) | 20) & 0xFu; }
#define XB_SPIN(cond, bar) do { unsigned _sp = 0; while (cond) { __builtin_amdgcn_s_sleep(1); \
    if ((++_sp & 255u) == 0u) { if (xb_ld(&(bar)[XB_TMO])) break; if (_sp > XB_SPIN_CAP) { atomicAdd(&(bar)[XB_TMO], 1u); break; } } } } while (0)

struct XcdBarrier {
    unsigned* bar; unsigned x;
    volatile LAS unsigned* st;
};

__device__ __forceinline__ XcdBarrier xcd_barrier_post(unsigned* bar, volatile LAS unsigned* st) {
    XcdBarrier b; b.bar = bar; b.x = xb_xcc_id(); b.st = st;
    if (threadIdx.x == 0) (void)xb_add(&bar[XB_XCNT(b.x)], 1u);
    return b;
}
__device__ __forceinline__ void xcd_barrier_complete(unsigned* bar, unsigned x, unsigned& nloc, unsigned& nx) {
    const unsigned G = gridDim.x * gridDim.y * gridDim.z;
    unsigned sum, cnt, mine, sp = 0u;
    for (;;) {
        sum = 0u; cnt = 0u; mine = 0u;
#pragma unroll
        for (unsigned j = 0; j < 16; ++j) { const unsigned c = xb_ld(&bar[XB_XCNT(j)]); sum += c; cnt += (c > 0u) ? 1u : 0u; mine = (j == x) ? c : mine; }
        if (sum == G) break;
        __builtin_amdgcn_s_sleep(1);
        if ((++sp & 255u) == 0u) { if (xb_ld(&bar[XB_TMO])) break; if (sp > XB_SPIN_CAP) { atomicAdd(&bar[XB_TMO], 1u); break; } }
    }
    nloc = mine > 0u ? mine : 1u; nx = cnt > 0u ? cnt : 1u;
}

__device__ __forceinline__ void xcd_barrier(const XcdBarrier& b, const bool is_t0) {
    asm volatile("s_waitcnt vmcnt(0)" ::: "memory");
    __syncthreads();
    if (is_t0) {
        unsigned* bar = b.bar;
        __builtin_amdgcn_s_waitcnt(0);
        unsigned nloc = b.st[0], nx = b.st[1];
        if (nloc == 0u) { xcd_barrier_complete(bar, b.x, nloc, nx); b.st[0] = nloc; b.st[1] = nx; }
        const unsigned old = xb_add(&bar[XB_XSUB(b.x)], 1u);
        const unsigned gen = old / nloc;
        if (old + 1u == (gen + 1u) * nloc) {
            __builtin_amdgcn_fence(__ATOMIC_RELEASE, "agent");
            asm volatile("s_waitcnt vmcnt(0)" ::: "memory");
            const unsigned og = xb_add(&bar[XB_TOP], 1u);
            const unsigned tg = og / nx;
            if (og + 1u == (tg + 1u) * nx) xb_add(&bar[XB_TOPGEN], 1u);
            else XB_SPIN(xb_ld(&bar[XB_TOPGEN]) == tg, bar);
            __builtin_amdgcn_fence(__ATOMIC_ACQUIRE, "agent");
            xb_add(&bar[XB_XGEN(b.x)], 1u);
            asm volatile("s_waitcnt vmcnt(0)" ::: "memory");
        } else {
            XB_SPIN(xb_ld(&bar[XB_XGEN(b.x)]) == gen, bar);
            __builtin_amdgcn_fence(__ATOMIC_ACQUIRE, "agent");
            asm volatile("s_waitcnt vmcnt(0)" ::: "memory");
        }
    }
    __syncthreads();
}
typedef unsigned v2u __attribute__((ext_vector_type(2)));
#ifndef MK_N_LAUNCHES
#define MK_N_LAUNCHES 1
#endif
constexpr int NWAVES = 8;
constexpr int BATCH = 2, SEQ = 8192, DM = 4096, M = BATCH * SEQ, INC = 7424, FF = 16384, PLE = 256, DEPTH = 2;
constexpr int C_AV = 0, C_AG = 1024, C_BG = 2048, C_CG = 3072, C_BX = 4096, C_Q = 5120, C_K = 6144, C_V = 6272, C_D = 6400;
constexpr float EPS = 1e-6f;
constexpr int N_PHASES = 18;
constexpr size_t MiB = 1u << 20;
constexpr size_t WS_CTL = 0, CTL_ZERO_BYTES = 1 * MiB;
constexpr size_t WS_W = 2 * MiB, W_LAYER = 388 * MiB;
constexpr size_t WO_IN = 0, WO_OUT = 58 * MiB, WO_UP = 90 * MiB, WO_DOWN = 218 * MiB, WO_G = 346 * MiB, WO_P = 378 * MiB, WO_PB = 380 * MiB;
constexpr size_t WS_H = 780 * MiB, WS_XN = 1036 * MiB, WS_PP = 1164 * MiB, WS_BIG = 1292 * MiB, WS_Y = WS_BIG + 232 * MiB, WS_SLOT = 1804 * MiB, WS_XN2 = 1808 * MiB, WS_END = 1936 * MiB;
constexpr size_t WS_RSTD = 1 * MiB + 512 * 1024;
constexpr int CW_BAR = 4096;
constexpr size_t WS_CWT = 1 * MiB;
constexpr int RING_BYTES = 131072, LDSCTL_OFF = RING_BYTES, MISC_OFF = LDSCTL_OFF + 320, LDS_BYTES = 147456;

struct Frame {
    LAS unsigned char* lds;
    volatile LAS unsigned* MISC;
    gu32* ctl;
    int wave, vcu, G;
};
__device__ __forceinline__ int fresh_lane() { int l; asm volatile("v_mbcnt_lo_u32_b32 %0, -1, 0\n\tv_mbcnt_hi_u32_b32 %0, -1, %0" : "=v"(l)); return l; }

__device__ __forceinline__ float wave_sum(float v) {
#pragma unroll
    for (int o = 1; o < 64; o <<= 1) v += __shfl_xor(v, o);
    return v;
}
__device__ __forceinline__ float bf2f(bf16 u) { return __builtin_bit_cast(float, (unsigned)u << 16); }
__device__ __forceinline__ float bflo(unsigned w) { return __builtin_bit_cast(float, w << 16); }
__device__ __forceinline__ float bfhi(unsigned w) { return __builtin_bit_cast(float, w & 0xffff0000u); }

__device__ __forceinline__ void tr_item(const float* W, int K, int ldw, int nblk, bf16* WT, LAS float* scr, int item, int lane) {
    const int kb = item / nblk, nb = item - kb * nblk, k0 = 64 * kb, n0 = 32 * nb;
#pragma unroll
    for (int i = 0; i < 32; ++i) { const int kk = 2 * i + (lane >> 5); scr[kk * 33 + (lane & 31)] = ((const GAS float*)W)[(size_t)(k0 + kk) * ldw + n0 + (lane & 31)]; }
    LDS_WAIT(); asm volatile("" ::: "memory");
    const int c = lane & 7;
#pragma unroll
    for (int j = 0; j < 4; ++j) { const int n = (lane >> 3) + 8 * j; const LAS float* s = scr + (8 * c) * 33 + n;
        v4u o; o.x = pk2(s[0 * 33], s[1 * 33]); o.y = pk2(s[2 * 33], s[3 * 33]); o.z = pk2(s[4 * 33], s[5 * 33]); o.w = pk2(s[6 * 33], s[7 * 33]);
        *(GAS v4u*)(WT + (size_t)(n0 + n) * K + k0 + 8 * c) = o; }
    LDS_WAIT(); asm volatile("" ::: "memory");
}
struct ProIn { const float *p, *w_in, *pool_w, *w_out, *w_up, *w_down, *w_g, *w_p, *conv_w; unsigned char* ws; };
__device__ __forceinline__ void prologue(Frame& F, const ProIn& I) {
    const int lane_ = fresh_lane();
    LAS float* scr = (LAS float*)(F.lds + F.wave * 16384);
    const int gw = F.vcu * NWAVES + F.wave, NGW = F.G * NWAVES;
    constexpr int I_IN = 64 * 200, I_OUT = 64 * 128, I_UP = 64 * 512, I_DOWN = 256 * 128, I_G = 64 * 128, I_P = 4 * 128;
    constexpr int I_LAYER = I_IN + I_OUT + I_UP + I_DOWN + I_G + I_P;
    for (int it = gw; it < DEPTH * I_LAYER; it += NGW) {
        const int L = it / I_LAYER; int r = it - L * I_LAYER;
        unsigned char* wl = I.ws + WS_W + (size_t)L * W_LAYER;
        if (r < I_IN) { tr_item(I.w_in + (size_t)L * DM * INC, DM, INC, 200, (bf16*)(wl + WO_IN), scr, r, lane_); continue; } r -= I_IN;
        if (r < I_OUT) { tr_item(I.w_out + (size_t)L * DM * DM, DM, DM, 128, (bf16*)(wl + WO_OUT), scr, r, lane_); continue; } r -= I_OUT;
        if (r < I_UP) { tr_item(I.w_up + (size_t)L * DM * FF, DM, FF, 512, (bf16*)(wl + WO_UP), scr, r, lane_); continue; } r -= I_UP;
        if (r < I_DOWN) { tr_item(I.w_down + (size_t)L * FF * DM, FF, DM, 128, (bf16*)(wl + WO_DOWN), scr, r, lane_); continue; } r -= I_DOWN;
        if (r < I_G) { tr_item(I.w_g + (size_t)L * DM * DM, DM, DM, 128, (bf16*)(wl + WO_G), scr, r, lane_); continue; } r -= I_G;
        tr_item(I.w_p + (size_t)L * PLE * DM, PLE, DM, 128, (bf16*)(wl + WO_P), scr, r, lane_);
    }
    for (int it = gw; it < DEPTH * 2048; it += NGW) {
        const int L = it >> 11, r = it & 2047, kblk = r & 63, g = (r >> 6) & 3, dch = r >> 8;
        const int k = kblk * 64 + lane_;
        const GAS float* a = (const GAS float*)I.w_in + (size_t)L * DM * INC + (size_t)k * INC + C_D + g * 256;
        const GAS float* pw = (const GAS float*)I.pool_w + (size_t)L * 4 * 65536 + (size_t)g * 65536 + dch * 32;
        float acc[32];
#pragma unroll
        for (int d = 0; d < 32; ++d) acc[d] = 0.f;
#pragma unroll 1
        for (int c4 = 0; c4 < 64; ++c4) { const f32x4 av = ((const GAS f32x4*)a)[c4];
#pragma unroll
            for (int e = 0; e < 4; ++e)
#pragma unroll
                for (int d = 0; d < 32; ++d) acc[d] += av[e] * pw[(c4 * 4 + e) * 256 + d]; }
        GAS bf16* o = (GAS bf16*)(I.ws + WS_W + (size_t)L * W_LAYER + WO_IN) + (size_t)(C_D + g * 256 + dch * 32) * DM + k;
#pragma unroll
        for (int d = 0; d < 32; ++d) o[(size_t)d * DM] = (bf16)f2bf(acc[d]);
    }
    for (int e = gw * 64 + lane_; e < DEPTH * 1024 * 32; e += NGW * 64) { const int L = e >> 15, c = (e >> 5) & 1023, k = e & 31;
        ((GAS float*)(I.ws + WS_CWT))[e] = (k < 31) ? ((const GAS float*)I.conv_w)[(size_t)L * 31 * 1024 + k * 1024 + c] : 0.f; }
    for (int ch = gw * 64 + lane_; ch < DEPTH * M * PLE / 8; ch += NGW * 64) {
        const int L = ch / (M * PLE / 8), r = ch - L * (M * PLE / 8);
        const f32x4 a = ((const GAS f32x4*)I.p)[2 * (size_t)ch], b = ((const GAS f32x4*)I.p)[2 * (size_t)ch + 1];
        v4u o; o.x = pk2(a.x, a.y); o.y = pk2(a.z, a.w); o.z = pk2(b.x, b.y); o.w = pk2(b.z, b.w);
        ((GAS v4u*)(I.ws + WS_W + (size_t)L * W_LAYER + WO_PB))[r] = o;
    }
}

__device__ __forceinline__ void norm_phase(Frame& F, const float* src, const float* g, bf16* dst_bf, float* dst_f) {
    const int lane_ = fresh_lane();
    const int gw = F.vcu * NWAVES + F.wave, NGW = F.G * NWAVES;
    for (int m = gw; m < M; m += NGW) {
        const GAS f32x4* xr = (const GAS f32x4*)(src + (size_t)m * DM) + lane_;
        f32x4 v[16]; float s = 0.f;
#pragma unroll
        for (int j = 0; j < 16; ++j) { v[j] = xr[64 * j]; s += (v[j].x * v[j].x + v[j].y * v[j].y) + (v[j].z * v[j].z + v[j].w * v[j].w); }
        const float rstd = 1.f / sqrtf(wave_sum(s) * (1.f / DM) + EPS);
        const GAS f32x4* gr = (const GAS f32x4*)g + lane_;
        if (dst_bf) { GAS unsigned long long* o8 = (GAS unsigned long long*)(dst_bf + (size_t)m * DM) + lane_;
#pragma unroll
            for (int j = 0; j < 16; ++j) { const f32x4 gv = gr[64 * j];
                o8[64 * j] = (unsigned long long)pk2(v[j].x * rstd * gv.x, v[j].y * rstd * gv.y) | ((unsigned long long)pk2(v[j].z * rstd * gv.z, v[j].w * rstd * gv.w) << 32); } }
        else { GAS f32x4* o = (GAS f32x4*)(dst_f + (size_t)m * DM) + lane_;
#pragma unroll
            for (int j = 0; j < 16; ++j) { const f32x4 gv = gr[64 * j]; o[64 * j] = (f32x4){v[j].x * rstd * gv.x, v[j].y * rstd * gv.y, v[j].z * rstd * gv.z, v[j].w * rstd * gv.w}; } }
    }
}

__device__ __forceinline__ void rowstat_phase(Frame& F, const float* slots, float* rstd) {
    const int lane_ = fresh_lane(); const int gt = (F.vcu * NWAVES + F.wave) * 64 + lane_, NT = F.G * NWAVES * 64;
    for (int r = gt; r < M; r += NT) { const GAS f32x4* sp = (const GAS f32x4*)(slots + (size_t)r * 64); float a = 0.f;
#pragma unroll
        for (int j = 0; j < 16; ++j) { const f32x4 v = sp[j]; a += (v.x + v.y) + (v.z + v.w); }
        ((GAS float*)rstd)[r] = 1.f / sqrtf(a * (1.f / DM) + EPS); }
}

struct MixP { const bf16* proj; bf16* Y; const float *conv_wt, *conv_b, *ln_g, *ln_b, *sconv_w, *sinks, *pool_scale, *gain; };

template <int N> __device__ __forceinline__ void block_reduce(float (&v)[N], LAS float* red, int wave, int lane, int tid) {
#pragma unroll
    for (int i = 0; i < N; ++i) v[i] = wave_sum(v[i]);
    if (lane == 0) {
#pragma unroll
        for (int i = 0; i < N; ++i) red[wave * N + i] = v[i]; }
    __syncthreads();
    if (tid < N) { float s = 0.f;
#pragma unroll
        for (int w = 0; w < NWAVES; ++w) s += red[w * N + tid];
        red[NWAVES * N + tid] = s; }
    __syncthreads();
#pragma unroll
    for (int i = 0; i < N; ++i) v[i] = red[NWAVES * N + i];
    __syncthreads();
}

__device__ __forceinline__ void stage_rows(const bf16* pj, int t_first, int nrows, int col0, LAS bf16* dst, int tid) {
#pragma unroll 8
    for (int it = tid; it < nrows * 128; it += NWAVES * 64) { const int r = it >> 7, ch = (it & 127) * 8; const int t = t_first + r;
        v4u v = (v4u){0u, 0u, 0u, 0u};
        if (t >= 0) v = *(const GAS v4u*)(pj + (size_t)t * INC + col0 + ch);
        *(LAS v4u*)(dst + r * 1024 + ch) = v; }
}
__device__ __forceinline__ float glu1(float val, float gt) { return val / (1.f + __expf(-gt)); }
__device__ __forceinline__ void mix_abd_tile(Frame& F, const MixP& P, int tile, LAS unsigned char* lds) {
    const int lane = fresh_lane(), wave = F.wave, tid = wave * 64 + lane;
    const int b = tile >> 9, t0 = (tile & 511) * 16;
    const bf16* pj = P.proj + (size_t)b * SEQ * INC;
    bf16* yo = P.Y + ((size_t)b * SEQ + t0) * DM;
    LAS bf16* L0 = (LAS bf16*)lds;
    LAS float* red = (LAS float*)(lds + 120 * 1024);
    {
#pragma unroll 4
        for (int it = tid; it < 46 * 128; it += NWAVES * 64) { const int r = it >> 7, ch = (it & 127) * 8; const int t = t0 - 30 + r;
            v4u o = (v4u){0u, 0u, 0u, 0u};
            if (t >= 0) { const bf16* row = pj + (size_t)t * INC + ch; const v4u va = *(const GAS v4u*)(row + C_AV), vg = *(const GAS v4u*)(row + C_AG);
                o.x = pk2(glu1(bflo(va.x), bflo(vg.x)), glu1(bfhi(va.x), bfhi(vg.x))); o.y = pk2(glu1(bflo(va.y), bflo(vg.y)), glu1(bfhi(va.y), bfhi(vg.y)));
                o.z = pk2(glu1(bflo(va.z), bflo(vg.z)), glu1(bfhi(va.z), bfhi(vg.z))); o.w = pk2(glu1(bflo(va.w), bflo(vg.w)), glu1(bfhi(va.w), bfhi(vg.w))); }
            *(LAS v4u*)(L0 + r * 1024 + ch) = o; }
        __syncthreads();
        float ya[2][16], st[32];
#pragma unroll
        for (int i = 0; i < 32; ++i) st[i] = 0.f;
#pragma unroll
        for (int cc = 0; cc < 2; ++cc) { const int c = tid + 512 * cc;
            float w[32];
            const GAS f32x4* wp = (const GAS f32x4*)(P.conv_wt + (size_t)c * 32);
#pragma unroll
            for (int k = 0; k < 8; ++k) { const f32x4 v = wp[k]; w[4 * k] = v.x; w[4 * k + 1] = v.y; w[4 * k + 2] = v.z; w[4 * k + 3] = v.w; }
            const float bias = ((const GAS float*)P.conv_b)[c];
            float a[16];
#pragma unroll
            for (int i = 0; i < 16; ++i) a[i] = bias;
            const LAS bf16* up = L0 + c;
#pragma unroll
            for (int j = 0; j < 46; ++j) { const float uv = bf2f(up[j * 1024]);
#pragma unroll
                for (int i = 0; i < 16; ++i) if (j - i >= 0 && j - i <= 30) a[i] += w[j - i] * uv; }
#pragma unroll
            for (int i = 0; i < 16; ++i) { ya[cc][i] = a[i]; st[i] += a[i]; st[16 + i] += a[i] * a[i]; } }
        block_reduce<32>(st, red, wave, lane, tid);
        float s2[16];
#pragma unroll
        for (int i = 0; i < 16; ++i) { const float mean = st[i] * (1.f / 1024.f); float var = st[16 + i] * (1.f / 1024.f) - mean * mean; var = var > 0.f ? var : 0.f;
            st[i] = mean; st[16 + i] = 1.f / sqrtf(var + EPS); s2[i] = 0.f; }
#pragma unroll
        for (int cc = 0; cc < 2; ++cc) { const int c = tid + 512 * cc; const float g = ((const GAS float*)P.ln_g)[c], bb = ((const GAS float*)P.ln_b)[c];
#pragma unroll
            for (int i = 0; i < 16; ++i) { const float x = (ya[cc][i] - st[i]) * st[16 + i] * g + bb; const float s = x / (1.f + __expf(-x)); ya[cc][i] = s; s2[i] += s * s; } }
        block_reduce<16>(s2, red, wave, lane, tid);
#pragma unroll
        for (int i = 0; i < 16; ++i) s2[i] = 1.f / sqrtf(s2[i] * (1.f / 1024.f) + EPS);
#pragma unroll
        for (int cc = 0; cc < 2; ++cc) { const int c = tid + 512 * cc; const float gn = ((const GAS float*)P.gain)[c]; GAS bf16* yp = (GAS bf16*)yo + c;
#pragma unroll
            for (int i = 0; i < 16; ++i) yp[(size_t)i * DM] = (bf16)f2bf(ya[cc][i] * s2[i] * gn); }
    }
    {
        LAS bf16* Lcg = L0, *Lx = L0 + 18 * 1024, *Lbg = L0 + 36 * 1024;
        stage_rows(pj, t0 - 2, 18, C_CG, Lcg, tid); stage_rows(pj, t0 - 2, 18, C_BX, Lx, tid); stage_rows(pj, t0, 16, C_BG, Lbg, tid);
        __syncthreads();
        float yb[2][16], s2[16];
#pragma unroll
        for (int i = 0; i < 16; ++i) s2[i] = 0.f;
#pragma unroll
        for (int cc = 0; cc < 2; ++cc) { const int c = tid + 512 * cc;
            const float w0 = ((const GAS float*)P.sconv_w)[c], w1 = ((const GAS float*)P.sconv_w)[1024 + c], w2 = ((const GAS float*)P.sconv_w)[2048 + c];
            float g[18];
#pragma unroll
            for (int j = 0; j < 18; ++j) g[j] = bf2f(Lcg[j * 1024 + c]) * bf2f(Lx[j * 1024 + c]);
#pragma unroll
            for (int i = 0; i < 16; ++i) { const float bg = bf2f(Lbg[i * 1024 + c]);
                const float v = bg * (w0 * g[i] + w1 * g[i + 1] + w2 * g[i + 2]); yb[cc][i] = v; s2[i] += v * v; } }
        block_reduce<16>(s2, red, wave, lane, tid);
#pragma unroll
        for (int i = 0; i < 16; ++i) s2[i] = 1.f / sqrtf(s2[i] * (1.f / 1024.f) + EPS);
#pragma unroll
        for (int cc = 0; cc < 2; ++cc) { const int c = tid + 512 * cc; const float gn = ((const GAS float*)P.gain)[1024 + c]; GAS bf16* yp = (GAS bf16*)yo + 1024 + c;
#pragma unroll
            for (int i = 0; i < 16; ++i) yp[(size_t)i * DM] = (bf16)f2bf(yb[cc][i] * s2[i] * gn); }
    }
    {
        stage_rows(pj, t0 - 15, 31, C_D, L0, tid);
        __syncthreads();
        float yd[2][16], s2[16];
#pragma unroll
        for (int i = 0; i < 16; ++i) s2[i] = 0.f;
#pragma unroll
        for (int cc = 0; cc < 2; ++cc) { const int c = tid + 512 * cc; const int gi = (wave >> 2) + 2 * cc; const int w = 2 << gi; const float ps = ((const GAS float*)P.pool_scale)[c];
            float z[31];
#pragma unroll
            for (int j = 0; j < 31; ++j) z[j] = bf2f(L0[j * 1024 + c]);
#pragma unroll
            for (int i = 0; i < 16; ++i) { float s = 0.f;
#pragma unroll
                for (int m = 0; m < 16; ++m) if (m < w) s += z[15 + i - m];
                const int tt = t0 + i; const int cnt = (tt + 1 < w) ? (tt + 1) : w;
                const float v = (s / (float)cnt - z[15 + i]) * ps; yd[cc][i] = v; s2[i] += v * v; } }
        block_reduce<16>(s2, red, wave, lane, tid);
#pragma unroll
        for (int i = 0; i < 16; ++i) s2[i] = 1.f / sqrtf(s2[i] * (1.f / 1024.f) + EPS);
#pragma unroll
        for (int cc = 0; cc < 2; ++cc) { const int c = tid + 512 * cc; const float gn = ((const GAS float*)P.gain)[3072 + c]; GAS bf16* yp = (GAS bf16*)yo + 3072 + c;
#pragma unroll
            for (int i = 0; i < 16; ++i) yp[(size_t)i * DM] = (bf16)f2bf(yd[cc][i] * s2[i] * gn); }
    }
}

__device__ __forceinline__ void mix_attn_tile(Frame& F, const MixP& P, int tile, LAS unsigned char* lds) {
    constexpr int KSP = 72, VTP = 200;
    LAS bf16* Ks = (LAS bf16*)lds;
    LAS bf16* Vt = (LAS bf16*)(lds + 55296);
    LAS float* ssq = (LAS float*)(lds + 55296 + 51200 + 256);
    LAS float* rsq = ssq + 1024;
    const int lane = fresh_lane(), wave = F.wave, tid = wave * 64 + lane;
    const int b = tile >> 7, t0 = (tile & 127) * 64;
    const bf16* pj = P.proj + (size_t)b * SEQ * INC;
    bf16* yo = P.Y + ((size_t)b * SEQ + t0) * DM + 2048;
#pragma unroll
    for (int r = 0; r < 6; ++r) { const int q = tid + 512 * r; const int kvh = q / 1536; const int rem = q - kvh * 1536; const int key = rem >> 3, dc = rem & 7; const int t = t0 - 128 + key;
        v4u kv = (v4u){0u, 0u, 0u, 0u}, vv = (v4u){0u, 0u, 0u, 0u};
        if (t >= 0) { const bf16* row = pj + (size_t)t * INC; kv = *(const GAS v4u*)(row + C_K + kvh * 64 + dc * 8); vv = *(const GAS v4u*)(row + C_V + kvh * 64 + dc * 8); }
        *(LAS v4u*)(Ks + (kvh * 192 + key) * KSP + dc * 8) = kv;
        const unsigned vw[4] = {vv.x, vv.y, vv.z, vv.w};
#pragma unroll
        for (int e = 0; e < 8; ++e) Vt[(kvh * 64 + dc * 8 + e) * VTP + key] = (bf16)((e & 1) ? (vw[e >> 1] >> 16) : (vw[e >> 1] & 0xffffu)); }
    __syncthreads();
    const int fr = lane & 15, fq = lane >> 4, kvh = wave >> 2;
#pragma unroll 1
    for (int hh = 0; hh < 2; ++hh) {
        const int head = wave * 2 + hh;
        const float slope = exp2f(-0.5f * (float)(head + 1)), sink = ((const GAS float*)P.sinks)[head];
#pragma unroll 1
        for (int qs = 0; qs < 4; ++qs) {
            const bf16* qrow = pj + (size_t)(t0 + 16 * qs + fr) * INC + C_Q + head * 64 + fq * 8;
            const bf16x8 q0 = *(const GAS bf16x8*)qrow, q1 = *(const GAS bf16x8*)(qrow + 32);
            f32x4 s[9];
#pragma unroll
            for (int j = 0; j < 9; ++j) { const LAS bf16* kp = Ks + (kvh * 192 + (qs + j) * 16 + fr) * KSP + fq * 8;
                const bf16x8 k0 = *(const LAS bf16x8*)kp, k1 = *(const LAS bf16x8*)(kp + 32);
                f32x4 a = (f32x4){0.f, 0.f, 0.f, 0.f};
                a = __builtin_amdgcn_mfma_f32_16x16x32_bf16(k0, q0, a, 0, 0, 0); a = __builtin_amdgcn_mfma_f32_16x16x32_bf16(k1, q1, a, 0, 0, 0); s[j] = a; }
            float mx = -3.0e38f;
#pragma unroll
            for (int j = 0; j < 9; ++j)
#pragma unroll
                for (int i = 0; i < 4; ++i) { const int dist = 128 + fr - 16 * j - 4 * fq - i; const int kr = (qs + j) * 16 + 4 * fq + i;
                    const bool valid = (dist >= 0) && (dist < 128) && (t0 - 128 + kr >= 0);
                    const float sc = valid ? (s[j][i] * 0.125f - slope * (float)dist) : -1e30f; s[j][i] = sc; mx = fmaxf(mx, sc); }
            mx = fmaxf(mx, __shfl_xor(mx, 16)); mx = fmaxf(mx, __shfl_xor(mx, 32));
            const float mm = fmaxf(mx, sink);
            float l = 0.f;
#pragma unroll
            for (int j = 0; j < 9; ++j)
#pragma unroll
                for (int i = 0; i < 4; ++i) { const float p = __expf(s[j][i] - mm); s[j][i] = p; l += p; }
            l += __shfl_xor(l, 16); l += __shfl_xor(l, 32);
            l += __expf(sink - mm);
            const float inv = 1.f / l;
            unsigned pk[9][2];
#pragma unroll
            for (int j = 0; j < 9; ++j) { pk[j][0] = pk2(s[j][0], s[j][1]); pk[j][1] = pk2(s[j][2], s[j][3]); }
            f32x4 o[4];
#pragma unroll
            for (int dt = 0; dt < 4; ++dt) o[dt] = (f32x4){0.f, 0.f, 0.f, 0.f};
#pragma unroll
            for (int kp = 0; kp < 5; ++kp) { const int j0 = 2 * kp, j1 = (kp == 4) ? 8 : 2 * kp + 1;
                v4u bw; bw.x = pk[j0][0]; bw.y = pk[j0][1]; bw.z = (kp == 4) ? 0u : pk[j1][0]; bw.w = (kp == 4) ? 0u : pk[j1][1];
                const bf16x8 bop = __builtin_bit_cast(bf16x8, bw);
#pragma unroll
                for (int dt = 0; dt < 4; ++dt) { const LAS bf16* vp = Vt + (kvh * 64 + dt * 16 + fr) * VTP + 4 * fq;
                    const v2u lo = *(const LAS v2u*)(vp + (qs + j0) * 16), hi = *(const LAS v2u*)(vp + (qs + j1) * 16);
                    const v4u aw = (v4u){lo.x, lo.y, hi.x, hi.y};
                    o[dt] = __builtin_amdgcn_mfma_f32_16x16x32_bf16(__builtin_bit_cast(bf16x8, aw), bop, o[dt], 0, 0, 0); } }
            float sq = 0.f;
#pragma unroll
            for (int dt = 0; dt < 4; ++dt) { o[dt] = o[dt] * inv; sq += (o[dt].x * o[dt].x + o[dt].y * o[dt].y) + (o[dt].z * o[dt].z + o[dt].w * o[dt].w);
                v2u w2; w2.x = pk2(o[dt].x, o[dt].y); w2.y = pk2(o[dt].z, o[dt].w);
                *(GAS v2u*)(yo + (size_t)(16 * qs + fr) * DM + head * 64 + dt * 16 + 4 * fq) = w2; }
            sq += __shfl_xor(sq, 16); sq += __shfl_xor(sq, 32);
            if (fq == 0) ssq[head * 64 + 16 * qs + fr] = sq;
        }
    }
    __syncthreads();
    if (tid < 64) { float s = 0.f;
#pragma unroll
        for (int h = 0; h < 16; ++h) s += ssq[h * 64 + tid];
        rsq[tid] = 1.f / sqrtf(s * (1.f / 1024.f) + EPS); }
    __syncthreads();
#pragma unroll 4
    for (int r = 0; r < 16; ++r) { const int ch = tid + 512 * r; const int q = ch >> 7, cc = (ch & 127) * 8;
        GAS bf16* p = (GAS bf16*)yo + (size_t)q * DM + cc; const v4u w = *(const GAS v4u*)p; const float rs = rsq[q];
        const f32x4 g0 = *(const GAS f32x4*)(P.gain + 2048 + cc), g1 = *(const GAS f32x4*)(P.gain + 2048 + cc + 4);
        v4u o; o.x = pk2(bflo(w.x) * rs * g0.x, bfhi(w.x) * rs * g0.y); o.y = pk2(bflo(w.y) * rs * g0.z, bfhi(w.y) * rs * g0.w);
        o.z = pk2(bflo(w.z) * rs * g1.x, bfhi(w.z) * rs * g1.y); o.w = pk2(bflo(w.w) * rs * g1.z, bfhi(w.w) * rs * g1.w);
        *(GAS v4u*)p = o; }
    __syncthreads();
}

struct Args { const float* in[20]; float* out; unsigned char* ws; int ph_lo, ph_hi; };
typedef __attribute__((address_space(4))) const unsigned char* kargp;
__device__ __forceinline__ const float* INP(int i) { kargp k = (kargp)__builtin_amdgcn_kernarg_segment_ptr(); asm volatile("" : "+s"(k)); return (const float*)(*(__attribute__((address_space(4))) const unsigned long long*)(k + 8 * i)); }

__global__ void __launch_bounds__(NWAVES * 64, 2) mk_fwd(Args args) {
    extern __shared__ __attribute__((aligned(16))) unsigned char lds[];
    Frame F;
    F.lds = (LAS unsigned char*)lds;
    F.MISC = (volatile LAS unsigned*)(F.lds + MISC_OFF);
    F.wave = __builtin_amdgcn_readfirstlane((int)threadIdx.x >> 6);
    F.G = gridDim.x; { const int bx = blockIdx.x; F.vcu = (F.G % 8 == 0) ? (bx % 8) * (F.G / 8) + bx / 8 : bx; }
#define WS_ ((unsigned char*)INP(21))
#define H_ ((float*)(WS_ + WS_H))
#define XN_ ((bf16*)(WS_ + WS_XN))
#define PP_ ((bf16*)(WS_ + WS_PP))
#define PROJ_ ((bf16*)(WS_ + WS_BIG))
#define Y_ ((bf16*)(WS_ + WS_Y))
#define UP_ ((bf16*)(WS_ + WS_BIG))
#define XN2_ ((bf16*)(WS_ + WS_XN2))
#define SLOT_ ((float*)(WS_ + WS_SLOT))
#define RSTD_ ((float*)(WS_ + WS_RSTD))
#define TAB_ (F.lds + LDSCTL_OFF + 512)
#define WL_(L, off) ((const bf16*)(WS_ + WS_W + (size_t)(L) * W_LAYER + (off)))
    F.ctl = (gu32*)(WS_ + WS_CTL);
    for (int u = threadIdx.x; u < (LDS_BYTES - LDSCTL_OFF) / 4; u += NWAVES * 64) ((LAS unsigned*)(F.lds + LDSCTL_OFF))[u] = 0u;
    __syncthreads();
    (void)xcd_barrier_post((unsigned*)(WS_ + WS_CTL) + CW_BAR, F.MISC + 8);
#define IN(k) true
#define SEAM(k) do { if (IN(k) && IN((k) + 1)) { XcdBarrier b_; b_.bar = (unsigned*)(WS_ + WS_CTL) + CW_BAR; b_.x = xb_xcc_id(); b_.st = F.MISC + 8; xcd_barrier(b_, (F.wave == 0) && (fresh_lane() == 0)); } } while (0)

    if (IN(0)) { ProIn I{INP(1), INP(3), INP(10), INP(13), INP(15), INP(16), INP(17), INP(18), INP(4), WS_}; prologue(F, I); norm_phase(F, INP(0), INP(2), XN_, nullptr); }
    SEAM(0);
#pragma unroll
    for (int L = 0; L < DEPTH; ++L) {
        const int pb = 1 + 8 * L;

        if (IN(pb + 1)) { pg8::Gemm g{(L == 0) ? XN_ : XN2_, WL_(L, WO_IN), M, INC, DM}; pg8::StaticOrder S; S.init(M, INC, F.G, (int)blockIdx.x);
            if (L != 0) pg8::build_rstd_tab(TAB_, S, SLOT_, F.wave * 64 + fresh_lane());
            pg8::EpiBf16<0> E{PROJ_, INC, (L == 0) ? nullptr : (const float*)SLOT_, TAB_}; pg8::gemm_phase<pg8::EpiBf16<0>, pg8::StaticOrder, true, true>(F.lds, g, S, E, F.wave);
            __syncthreads();
            { const int c0 = ((M / 256) * (INC / 256)) % F.G;
              if ((int)blockIdx.x >= c0) { pg8::Gemm g2{WL_(L, WO_PB), WL_(L, WO_P), M, DM, PLE}; pg8::StaticOrder S2; S2.init(M, DM, F.G - c0, (int)blockIdx.x - c0);
                pg8::EpiBf16<0> E2{PP_, DM, nullptr, TAB_}; pg8::gemm_phase<pg8::EpiBf16<0>, pg8::StaticOrder, true, true>(F.lds, g2, S2, E2, F.wave); } } }
        SEAM(pb + 1);
        if (IN(pb + 2)) {
            MixP P{PROJ_, Y_, (const float*)(WS_ + WS_CWT) + (size_t)L * 32 * 1024, INP(5) + (size_t)L * 1024, INP(6) + (size_t)L * 1024, INP(7) + (size_t)L * 1024,
                   INP(8) + (size_t)L * 3 * 1024, INP(9) + (size_t)L * 16, INP(11) + (size_t)L * 1024, INP(12) + (size_t)L * DM};
            for (int tile = F.vcu; tile < BATCH * SEQ / 64; tile += F.G) mix_attn_tile(F, P, tile, F.lds);
            for (int tile = F.vcu; tile < BATCH * SEQ / 16; tile += F.G) mix_abd_tile(F, P, tile, F.lds);
        }
        SEAM(pb + 2);
        if (IN(pb + 3)) { pg8::Gemm g{Y_, WL_(L, WO_OUT), M, DM, DM}; pg8::StaticOrder S; S.init(M, DM, F.G, (int)blockIdx.x);
            pg8::EpiRes E{(L == 0) ? INP(0) : (const float*)H_, H_, XN_, DM, INP(14) + (size_t)L * DM, SLOT_}; pg8::gemm_phase<pg8::EpiRes, pg8::StaticOrder, true, true>(F.lds, g, S, E, F.wave); }
        SEAM(pb + 3);
        if (IN(pb + 5)) { pg8::Gemm g{XN_, WL_(L, WO_UP), M, FF, DM}; pg8::StaticOrder S; S.init(M, FF, F.G, (int)blockIdx.x);
            pg8::build_rstd_tab(TAB_, S, SLOT_, F.wave * 64 + fresh_lane());
            pg8::EpiBf16<2> E{UP_, FF, SLOT_, TAB_}; pg8::gemm_phase<pg8::EpiBf16<2>, pg8::StaticOrder, true, true>(F.lds, g, S, E, F.wave); }
        SEAM(pb + 5);
        if (IN(pb + 6)) {
            { pg8::Gemm g{UP_, WL_(L, WO_DOWN), M, DM, FF}; pg8::StaticOrder S; S.init(M, DM, F.G, (int)blockIdx.x);
              pg8::EpiRes E{H_, H_, XN_, DM, nullptr, nullptr}; pg8::gemm_phase<pg8::EpiRes, pg8::StaticOrder, true, true>(F.lds, g, S, E, F.wave); }
        }
        SEAM(pb + 6);
        if (IN(pb + 7)) { pg8::Gemm g{XN_, WL_(L, WO_G), M, DM, DM}; pg8::StaticOrder S; S.init(M, DM, F.G, (int)blockIdx.x);
            pg8::EpiGate E{H_, PP_, DM, (L + 1 < DEPTH) ? XN2_ : nullptr, INP(2) + (size_t)(L + 1 < DEPTH ? L + 1 : 0) * DM, SLOT_}; pg8::gemm_phase<pg8::EpiGate, pg8::StaticOrder, true, true>(F.lds, g, S, E, F.wave); }
        SEAM(pb + 7);
    }
    if (IN(17)) norm_phase(F, H_, INP(19), nullptr, (float*)INP(20));
#undef IN
#undef SEAM
}

extern "C" void kernel_launch(void* const* d_in, const int* in_sizes, int n_in, void* d_out, int out_size, void* d_ws, size_t ws_size, hipStream_t stream) {
    static int grid = 0;
    if (grid == 0) {
        if (n_in != 20 || in_sizes[0] != M * DM || out_size != M * DM || ws_size < WS_END) { fprintf(stderr, "kernel_launch: unexpected shapes (n_in %d, in0 %d, out %d, ws %zu); nothing launched\n", n_in, n_in > 0 ? in_sizes[0] : -1, out_size, ws_size); grid = -1; return; }
        int dev = 0, cus = 0, per_cu = 0;
        if (hipGetDevice(&dev) != hipSuccess || hipDeviceGetAttribute(&cus, hipDeviceAttributeMultiprocessorCount, dev) != hipSuccess) { grid = -1; return; }
        if (hipFuncSetAttribute((const void*)mk_fwd, hipFuncAttributeMaxDynamicSharedMemorySize, LDS_BYTES) != hipSuccess) { fprintf(stderr, "kernel_launch: hipFuncSetAttribute failed\n"); grid = -1; return; }
        if (hipOccupancyMaxActiveBlocksPerMultiprocessor(&per_cu, (const void*)mk_fwd, NWAVES * 64, LDS_BYTES) != hipSuccess || per_cu < 1)
            fprintf(stderr, "kernel_launch: note: occupancy query reports %d workgroups per CU\n", per_cu);
        (void)hipGetLastError();
        grid = cus;
    }
    if (grid < 0) return;
    if (hipMemsetAsync((char*)d_ws + WS_CTL, 0, CTL_ZERO_BYTES, stream) != hipSuccess) return;
    Args a{};
    for (int i = 0; i < 20; ++i) a.in[i] = (const float*)d_in[i];
    a.out = (float*)d_out; a.ws = (unsigned char*)d_ws;
#if MK_N_LAUNCHES == 1
    a.ph_lo = 0; a.ph_hi = N_PHASES;
    hipLaunchKernelGGL(mk_fwd, dim3(grid), dim3(NWAVES * 64), LDS_BYTES, stream, a);
#else
#error single launch only
#endif
    const hipError_t le = hipPeekAtLastError();
    if (le != hipSuccess) fprintf(stderr, "kernel_launch: launch failed: %s\n", hipGetErrorName(le));
}
```
